# Optimizing an MI355X kernel written in HIP

```python
import math
import jax, jax.numpy as jnp
from jax import lax
import numpy as np

D_MODEL = 1024
BATCH = 32
SEQ = 256
DEPTH = 2
DEC_BATCH = 8
DEC_SEQ = 1024
PAST_LEN = 256

GRID_W = 64
CHUNK = 128
Q_BLOCK = 128
EPS = 1e-6
ROPE_BASE = 10000.0
W_A = 256
G_A = 4
DG_A = W_A // G_A
H_B = 4
DK_B = 64
DV_B = 64
W_B = H_B * DV_B
H_C = 4
HD_C = 64
DV_C = 2 * HD_C
W_C = H_C * DV_C
ROPE_PAIRS = HD_C // 4
MIX_W = W_A + W_B + W_C
IN_A = 2 * W_A
IN_B = 2 * H_B * DK_B + 2 * W_B
IN_C = 2 * H_C * 2 * HD_C + W_C
IN_W = IN_A + IN_B + IN_C
D_FF = 2816
CONV_W = 3

kernel_name = 'hybrid_dit_prefix_step'


def rms_norm(x, g):
    xf = x.astype(jnp.float32)
    y = xf * lax.rsqrt(jnp.mean(xf * xf, axis=-1, keepdims=True) + EPS)
    return (y * g.astype(jnp.float32)).astype(x.dtype)


def adaln(cond2d, w_mod_l, b_mod_l):
    m = jax.nn.silu(cond2d) @ w_mod_l + b_mod_l
    return jnp.split(m[:, None, :], 6, axis=-1)


def axial_rope_angles(L):
    rows = L // GRID_W
    t_row = jnp.repeat(jnp.arange(rows, dtype=jnp.float32), GRID_W)
    t_col = jnp.tile(jnp.arange(GRID_W, dtype=jnp.float32), rows)
    inv = ROPE_BASE ** (-jnp.arange(ROPE_PAIRS, dtype=jnp.float32) / ROPE_PAIRS)
    return t_row[:, None] * inv, t_col[:, None] * inv


def _rotate(x, ang):
    x1, x2 = x[..., :ROPE_PAIRS], x[..., ROPE_PAIRS:]
    cos = jnp.cos(ang)[:, None, None, :]
    sin = jnp.sin(ang)[:, None, None, :]
    return jnp.concatenate([x1 * cos - x2 * sin, x1 * sin + x2 * cos], axis=-1)


def apply_axial_rope(x, ang_row, ang_col):
    xf = x.astype(jnp.float32)
    half = HD_C // 2
    out = jnp.concatenate([_rotate(xf[..., :half], ang_row), _rotate(xf[..., half:], ang_col)], axis=-1)
    return out.astype(x.dtype)


def chunk_sgu(z, norm_g, w_s, b_s):
    B, L, _ = z.shape
    u, v = jnp.split(jax.nn.gelu(z), 2, axis=-1)
    v = rms_norm(v, norm_g)
    vg = v.reshape(B, L // CHUNK, CHUNK, G_A, DG_A)
    s = jnp.einsum('gpq,bnqgc->bnpgc', w_s, vg) + b_s.T[None, None, :, :, None]
    return u * s.reshape(B, L, W_A)


def retention_chunked(q, k, v, log_gamma, r0):
    B, L, H, _ = q.shape
    dv = v.shape[-1]
    n = L // CHUNK

    def chunks(t):
        return t.astype(jnp.float32).reshape(B, n, CHUNK, H, t.shape[-1]).transpose(1, 0, 3, 2, 4)

    pos = jnp.arange(CHUNK, dtype=jnp.float32)
    dist = pos[:, None] - pos[None, :]
    lg = log_gamma[:, None, None]
    decay_mat = jnp.where(dist >= 0, jnp.exp(lg * jnp.maximum(dist, 0.0)), 0.0)
    q_decay = jnp.exp(log_gamma[:, None] * (pos + 1.0))[:, :, None]
    k_decay = jnp.exp(log_gamma[:, None] * (CHUNK - 1.0 - pos))[:, :, None]
    chunk_decay = jnp.exp(log_gamma * CHUNK)[:, None, None]

    def step(r, inp):
        qc, kc, vc = inp
        inner = jnp.einsum('bhqd,bhkd->bhqk', qc, kc) * decay_mat
        o = jnp.einsum('bhqk,bhke->bhqe', inner, vc) + jnp.einsum('bhqd,bhde->bhqe', qc, r) * q_decay
        r_new = r * chunk_decay + jnp.einsum('bhkd,bhke->bhde', kc * k_decay, vc)
        return r_new, o

    r_fin, o = lax.scan(step, r0.astype(jnp.float32), (chunks(q), chunks(k), chunks(v)))
    o = o.transpose(1, 0, 3, 2, 4).reshape(B, L, H, dv)
    return o, r_fin


def bidirectional_retention(q, k, v, logit_f, logit_b, r0_f, r0_b):
    lg_f = jax.nn.log_sigmoid(logit_f.astype(jnp.float32))
    lg_b = jax.nn.log_sigmoid(logit_b.astype(jnp.float32))
    o_f, r_f = retention_chunked(q, k, v, lg_f, r0_f)
    o_b, r_b = retention_chunked(q[:, ::-1], k[:, ::-1], v[:, ::-1], lg_b, r0_b)
    return o_f + o_b[:, ::-1], r_f, r_b


def diff_attention(q, k, v, lam, lam_init, norm_g):
    B, Lq = q.shape[:2]
    nb = Lq // Q_BLOCK
    qb = q.astype(jnp.float32).reshape(B, nb, Q_BLOCK, H_C, 2, HD_C).transpose(1, 0, 2, 3, 4, 5)
    kf = k.astype(jnp.float32)
    vf = v.astype(jnp.float32)
    scale = HD_C ** -0.5

    def block(qq):
        s = jnp.einsum('bqhid,bkhid->bhiqk', qq, kf) * scale
        p = jax.nn.softmax(s, axis=-1)
        a = p[:, :, 0] - lam * p[:, :, 1]
        return jnp.einsum('bhqk,bkhe->bqhe', a, vf)

    o = lax.map(block, qb)
    o = o.transpose(1, 0, 2, 3, 4).reshape(B, Lq, H_C, DV_C)
    o = rms_norm(o, norm_g) * (1.0 - lam_init)
    return o.astype(q.dtype).reshape(B, Lq, W_C)


def conv_ffn(h, lp):
    up = h @ lp['ffn_up']
    pad = jnp.pad(up, ((0, 0), (1, 1), (0, 0)))
    w = lp['ffn_conv']
    y = pad[:, :-2] * w[0] + pad[:, 1:-1] * w[1] + pad[:, 2:] * w[2] + lp['ffn_conv_b']
    a, b = jnp.split(y, 2, axis=-1)
    return (jax.nn.silu(a) * b) @ lp['ffn_down']


def mixing(h, lp, lam_init, cache):
    B, L, _ = h.shape
    z = h @ lp['w_in']
    za, zb, zc = jnp.split(z, [IN_A, IN_A + IN_B], axis=-1)
    y_a = chunk_sgu(za, lp['sgu_norm'], lp['sgu_w'], lp['sgu_b'])
    qb, kb, vb, gb = jnp.split(zb, 4, axis=-1)
    qb = qb.reshape(B, L, H_B, DK_B)
    kb = kb.reshape(B, L, H_B, DK_B) * (DK_B ** -0.5)
    vb = vb.reshape(B, L, H_B, DV_B)
    if cache is None:
        r0_f = jnp.zeros((B, H_B, DK_B, DV_B), jnp.float32)
        r0_b = r0_f
    else:
        r0_f, r0_b = cache[2], cache[3]
    o_ret, r_f, r_b = bidirectional_retention(qb, kb, vb, lp['ret_logit_fwd'], lp['ret_logit_bwd'], r0_f, r0_b)
    o_ret = rms_norm(o_ret.astype(h.dtype), lp['ret_norm'])
    y_b = jax.nn.silu(gb) * o_ret.reshape(B, L, W_B)
    qc, kc, vc = jnp.split(zc, [H_C * 2 * HD_C, 2 * H_C * 2 * HD_C], axis=-1)
    qc = rms_norm(qc.reshape(B, L, H_C, 2, HD_C), lp['q_norm'])
    kc = rms_norm(kc.reshape(B, L, H_C, 2, HD_C), lp['k_norm'])
    vc = vc.reshape(B, L, H_C, DV_C)
    dl = lp['diff_lam'].astype(jnp.float32)
    lam = jnp.exp(jnp.sum(dl[0] * dl[1])) - jnp.exp(jnp.sum(dl[2] * dl[3])) + lam_init
    if cache is None:
        keys, vals = kc, vc
        new_ctx = (kc, vc, r_f.astype(h.dtype), r_b.astype(h.dtype))
    else:
        ang_row, ang_col = axial_rope_angles(L)
        qc = apply_axial_rope(qc, ang_row, ang_col)
        keys = jnp.concatenate([cache[0], apply_axial_rope(kc, ang_row, ang_col)], axis=1)
        vals = jnp.concatenate([cache[1], vc], axis=1)
        new_ctx = None
    y_c = diff_attention(qc, keys, vals, lam, lam_init, lp['diff_norm'])
    y = jnp.concatenate([y_a, y_b, y_c], axis=-1) @ lp['w_out']
    return y, new_ctx


def trunk_layer(x, mods, lp, lam_init, cache):
    sh1, sc1, g1, sh2, sc2, g2 = mods
    h = rms_norm(x, lp['norm1']) * (1.0 + sc1) + sh1
    y, new_ctx = mixing(h, lp, lam_init, cache)
    x = x + g1 * y
    h = rms_norm(x, lp['norm2']) * (1.0 + sc2) + sh2
    x = x + g2 * conv_ffn(h, lp)
    return x, new_ctx


def setup_inputs(seed: int = 0) -> dict:
    key = jax.random.key(seed)
    ks = jax.random.split(key, 32)
    nrm = lambda i, shape, s: jax.random.normal(ks[i], shape, jnp.float32) * s
    base_gamma = 1.0 - 2.0 ** (-5.0 - np.arange(H_B, dtype=np.float32))
    base_logit = jnp.asarray(np.log(base_gamma / (1.0 - base_gamma)), jnp.float32)
    return {
        'x_prompt': nrm(0, (BATCH, SEQ, D_MODEL), 1.0),
        'x_sample': nrm(1, (DEC_BATCH, DEC_SEQ, D_MODEL), 1.0),
        'c': nrm(2, (DEC_BATCH, D_MODEL), 1.0),
        'cache_k': nrm(3, (DEC_BATCH, DEPTH, PAST_LEN, H_C, 2, HD_C), 1.0),
        'cache_v': nrm(4, (DEC_BATCH, DEPTH, PAST_LEN, H_C, DV_C), 1.0),
        'state_ret_fwd': nrm(5, (DEC_BATCH, DEPTH, H_B, DK_B, DV_B), 1.0),
        'state_ret_bwd': nrm(6, (DEC_BATCH, DEPTH, H_B, DK_B, DV_B), 1.0),
        'c_ctx': nrm(7, (D_MODEL,), 1.0),
        'norm1': 1.0 + nrm(8, (DEPTH, D_MODEL), 0.02),
        'w_mod': nrm(9, (DEPTH, D_MODEL, 6 * D_MODEL), 0.5 * D_MODEL ** -0.5),
        'b_mod': nrm(10, (DEPTH, 6 * D_MODEL), 0.02),
        'w_in': nrm(11, (DEPTH, D_MODEL, IN_W), D_MODEL ** -0.5),
        'sgu_norm': 1.0 + nrm(12, (DEPTH, W_A), 0.02),
        'sgu_w': nrm(13, (DEPTH, G_A, CHUNK, CHUNK), CHUNK ** -0.5),
        'sgu_b': 1.0 + nrm(14, (DEPTH, G_A, CHUNK), 0.01),
        'ret_logit_fwd': base_logit + nrm(15, (DEPTH, H_B), 0.1),
        'ret_logit_bwd': base_logit + nrm(16, (DEPTH, H_B), 0.1),
        'ret_norm': 1.0 + nrm(17, (DEPTH, H_B, DV_B), 0.02),
        'q_norm': 1.0 + nrm(18, (DEPTH, HD_C), 0.02),
        'k_norm': 1.0 + nrm(19, (DEPTH, HD_C), 0.02),
        'diff_lam': nrm(20, (DEPTH, 4, HD_C), 0.1),
        'diff_norm': 1.0 + nrm(21, (DEPTH, DV_C), 0.02),
        'w_out': nrm(22, (DEPTH, MIX_W, D_MODEL), MIX_W ** -0.5),
        'norm2': 1.0 + nrm(23, (DEPTH, D_MODEL), 0.02),
        'ffn_up': nrm(24, (DEPTH, D_MODEL, 2 * D_FF), D_MODEL ** -0.5),
        'ffn_conv': nrm(25, (DEPTH, CONV_W, 2 * D_FF), CONV_W ** -0.5),
        'ffn_conv_b': nrm(26, (DEPTH, 2 * D_FF), 0.01),
        'ffn_down': nrm(27, (DEPTH, D_FF, D_MODEL), D_FF ** -0.5),
    }


def reference(x_prompt, x_sample, c, cache_k, cache_v, state_ret_fwd, state_ret_bwd, c_ctx,
              norm1, w_mod, b_mod, w_in, sgu_norm, sgu_w, sgu_b, ret_logit_fwd, ret_logit_bwd,
              ret_norm, q_norm, k_norm, diff_lam, diff_norm, w_out, norm2, ffn_up, ffn_conv,
              ffn_conv_b, ffn_down):
    def layer_params(l):
        return dict(norm1=norm1[l], w_in=w_in[l], sgu_norm=sgu_norm[l], sgu_w=sgu_w[l], sgu_b=sgu_b[l],
                    ret_logit_fwd=ret_logit_fwd[l], ret_logit_bwd=ret_logit_bwd[l], ret_norm=ret_norm[l],
                    q_norm=q_norm[l], k_norm=k_norm[l], diff_lam=diff_lam[l], diff_norm=diff_norm[l],
                    w_out=w_out[l], norm2=norm2[l], ffn_up=ffn_up[l], ffn_conv=ffn_conv[l],
                    ffn_conv_b=ffn_conv_b[l], ffn_down=ffn_down[l])

    y_prompt = x_prompt
    ks_out, vs_out, rf_out, rb_out = [], [], [], []
    for l in range(DEPTH):
        lam_init = 0.8 - 0.6 * math.exp(-0.3 * l)
        mods = adaln(c_ctx[None, :], w_mod[l], b_mod[l])
        y_prompt, (k_l, v_l, rf_l, rb_l) = trunk_layer(y_prompt, mods, layer_params(l), lam_init, None)
        ks_out.append(k_l)
        vs_out.append(v_l)
        rf_out.append(rf_l)
        rb_out.append(rb_l)
    new_cache_k = jnp.stack(ks_out, axis=1)
    new_cache_v = jnp.stack(vs_out, axis=1)
    new_state_ret_fwd = jnp.stack(rf_out, axis=1)
    new_state_ret_bwd = jnp.stack(rb_out, axis=1)

    y_sample = x_sample
    for l in range(DEPTH):
        lam_init = 0.8 - 0.6 * math.exp(-0.3 * l)
        mods = adaln(c, w_mod[l], b_mod[l])
        cache_l = (cache_k[:, l], cache_v[:, l], state_ret_fwd[:, l], state_ret_bwd[:, l])
        y_sample, _ = trunk_layer(y_sample, mods, layer_params(l), lam_init, cache_l)

    return (y_prompt, y_sample, new_cache_k, new_cache_v, new_state_ret_fwd, new_state_ret_bwd)
```

```cpp
#include <hip/hip_runtime.h>
#include <hip/hip_cooperative_groups.h>
#include <cstdio>
#include <cstdint>
namespace cg = cooperative_groups;
#ifndef KL_COOP
#define KL_COOP 1
#endif
namespace pg8 {
#define PG8_LAS __attribute__((address_space(3)))
typedef unsigned short bf16_t;
typedef short bf16x8 __attribute__((ext_vector_type(8)));
typedef float f32x4 __attribute__((ext_vector_type(4)));
typedef unsigned u32x4 __attribute__((ext_vector_type(4)));
constexpr int BM = 256, BK = 64, HALF = 128, HTB = HALF * BK * 2  , STAGE_BYTES = 8 * HTB, NXCD = 8, WGM = 8;

__host__ __device__ __forceinline__ int lds_byte(int r, int c) { const int st = (r >> 4) * 2 + (c >> 5), rr = r & 15, cc = c & 31, ob = rr * 64 + cc * 2; return st * 1024 + (ob ^ (((ob >> 9) & 1) << 5)); }
__host__ __device__ __forceinline__ void stage_rc(int b, int& R, int& C) { const int st = b / 1024, sb = b % 1024, swz = sb ^ (((sb >> 9) & 1) << 5); R = (st >> 1) * 16 + swz / 64; C = (st & 1) * 32 + (swz % 64) / 2; }
__host__ __device__ __forceinline__ int perm32(int rho) { const int n = rho >> 4, i = rho & 15; return 8 * (i >> 2) + 4 * n + (i & 3); }

struct Unit { int pm, pn; };
struct Gemm { const bf16_t* A; const bf16_t* Bt; int M, N, K; };

struct StaticOrder {
    int nM, nN, nwg, G, c;
    __host__ __device__ void init(int M, int N, int G_, int c_) { nM = M / BM; nN = N / BM; nwg = nM * nN; G = G_; c = c_; }
    __host__ __device__ bool next(int i, Unit& u) const {
        const long L = (long)i * G + c; if (L >= nwg) return false;
        int wgid = (int)L; { const int q = nwg / NXCD, r = nwg % NXCD, xcd = wgid % NXCD, off = wgid / NXCD; wgid = (xcd < r ? xcd * (q + 1) : r * (q + 1) + (xcd - r) * q) + off; }
        const int nig = WGM * nN, gid = wgid / nig, fm = gid * WGM, gsz = (nM - fm) < WGM ? (nM - fm) : WGM;
        u.pm = fm + ((wgid % nig) % gsz); u.pn = (wgid % nig) / gsz; return true;
    }
    __device__ __forceinline__ void a_ready(const Unit&) const {}
    __device__ __forceinline__ void done(const Unit&) const {}
};

__device__ __forceinline__ unsigned cvt_pk_bf16(float lo, float hi) { unsigned r; asm volatile("v_cvt_pk_bf16_f32 %0, %1, %2" : "=v"(r) : "v"(lo), "v"(hi)); return r; }
typedef float f32x2 __attribute__((ext_vector_type(2)));
__device__ __forceinline__ f32x2 gelu_pk(f32x2 v) {
    const f32x2 av = __builtin_elementwise_abs(v), d = av * 0.2316418882f + 1.0f;
    f32x2 t; t.x = __builtin_amdgcn_rcpf(d.x); t.y = __builtin_amdgcn_rcpf(d.y);
    f32x2 q = t * 0.5307027145f + (-0.7265760135f); q = q * t + 0.7107068705f; q = q * t + (-0.142248368f); q = q * t + 0.127414796f; q = q * t;
    const f32x2 s = (v * v) * (-0.72134752044f);
    f32x2 e; e.x = __builtin_amdgcn_exp2f(s.x); e.y = __builtin_amdgcn_exp2f(s.y);
    const f32x2 m = v * (q * e), r = v - m;
    f32x2 o; o.x = v.x < 0.f ? m.x : r.x; o.y = v.y < 0.f ? m.y : r.y; return o;
}

template <int ACT  > struct EpiBf16 {
    static constexpr bool PERM = true, AFTER_DRAIN = false; static_assert(ACT == 0 || ACT == 1, "EpiBf16: ACT is 0 (none) or 1 (gelu_pk)");
    bf16_t* O; int ldc; const float* bias; int split_cols; size_t split_stride; float scale0;
    __device__ __forceinline__ void operator()(const f32x4 (&acc)[2][2][4][2], const Unit& u, int wr, int wc, int fr, int fq) const {
        const int row0 = u.pm * BM + wr * 64 + fr; int colt = u.pn * BM; bf16_t* base = O;
        float sc = 1.f; if (split_cols) { const int t = colt / split_cols; base += (size_t)t * split_stride; colt -= t * split_cols; if (t == 0) sc = scale0; }
        const int col0 = colt + wc * 32 + 8 * fq, bcol0 = u.pn * BM + wc * 32 + 8 * fq;
        f32x4 bv[2][2];
#pragma unroll
        for (int bj = 0; bj < 2; ++bj)
#pragma unroll
            for (int n = 0; n < 2; ++n) bv[bj][n] = bias ? *(const f32x4*)(bias + bcol0 + bj * HALF + 4 * n) : (f32x4){0.f, 0.f, 0.f, 0.f};
#pragma unroll
        for (int ai = 0; ai < 2; ++ai)
#pragma unroll
            for (int m = 0; m < 4; ++m) { bf16_t* rowp = base + (size_t)(row0 + ai * HALF + m * 16) * ldc + col0;
#pragma unroll
                for (int bj = 0; bj < 2; ++bj) { f32x4 v0 = acc[ai][bj][m][0] + bv[bj][0], v1 = acc[ai][bj][m][1] + bv[bj][1];
                    if (ACT == 1) { f32x2 a = gelu_pk((f32x2){v0[0], v0[1]}), b = gelu_pk((f32x2){v0[2], v0[3]}), c = gelu_pk((f32x2){v1[0], v1[1]}), d = gelu_pk((f32x2){v1[2], v1[3]});
                        v0 = (f32x4){a.x, a.y, b.x, b.y}; v1 = (f32x4){c.x, c.y, d.x, d.y}; }
                    v0 = v0 * sc; v1 = v1 * sc; u32x4 w; w.x = cvt_pk_bf16(v0[0], v0[1]); w.y = cvt_pk_bf16(v0[2], v0[3]); w.z = cvt_pk_bf16(v1[0], v1[1]); w.w = cvt_pk_bf16(v1[2], v1[3]);
                    *(u32x4*)(rowp + bj * HALF) = w; } }
    }
};
template <class Epi, class Sched, bool ALIGN_EPI = false, bool SP2 = false>
__device__ __forceinline__ void gemm_phase(PG8_LAS unsigned char* lds, const Gemm g, const Sched& S, const Epi& E) {
    int tid_ = threadIdx.x; asm volatile("" : "+v"(tid_));
    const int tid = tid_, wid = __builtin_amdgcn_readfirstlane(tid >> 6), lane = tid & 63, wr = wid >> 2, wc = wid & 3, fr = lane & 15, fq = lane >> 4;
    const int K = g.K, nt = K / BK;
    unsigned voffA[2], voffB[2];
#pragma unroll
    for (int i = 0; i < 2; ++i) { int R, C; stage_rc(tid * 16 + i * 8192, R, C); const int Rb = Epi::PERM ? ((R & ~31) + perm32(R & 31)) : R;
        voffA[i] = (unsigned)(R * K + C) * 2u; voffB[i] = (unsigned)(Rb * K + C) * 2u; }
    const size_t kstep = (size_t)(BK * 2);
    const size_t hstep = (size_t)HALF * K * 2;
    const size_t tstep = 2 * hstep;
    const unsigned ldsw = (unsigned)wid * 1024u;
    const int aoff = lds_byte(wr * 64 + fr, fq * 8), boff = lds_byte(wc * 32 + fr, fq * 8);
#define PG8_SA(b, h) (((b) * 2 + (h)) * HTB)
#define PG8_SB(b, h) ((4 + (b) * 2 + (h)) * HTB)
#define PG8_STAGE(bufoff, gbase, voff) do { _Pragma("unroll") for (int _i = 0; _i < 2; ++_i) \
        __builtin_amdgcn_global_load_lds((const unsigned*)((const char*)(gbase) + (voff)[_i]), (PG8_LAS unsigned*)(lds + (bufoff) + ldsw + _i * 8192), 16, 0, 0); } while (0)
#define PG8_LDA(dst, b, h) do { _Pragma("unroll") for (int m = 0; m < 4; ++m) _Pragma("unroll") for (int k = 0; k < 2; ++k) dst[m][k] = *(const PG8_LAS bf16x8*)(lds + PG8_SA(b, h) + aoff + m * 2048 + k * 1024); } while (0)
#define PG8_LDB(dst, b, h) do { _Pragma("unroll") for (int n = 0; n < 2; ++n) _Pragma("unroll") for (int k = 0; k < 2; ++k) dst[n][k] = *(const PG8_LAS bf16x8*)(lds + PG8_SB(b, h) + boff + n * 2048 + k * 1024); } while (0)
#define PG8_MMA(ai, bj, At, Bt) do { __builtin_amdgcn_s_setprio(1); _Pragma("unroll") for (int m = 0; m < 4; ++m) _Pragma("unroll") for (int n = 0; n < 2; ++n) _Pragma("unroll") for (int k = 0; k < 2; ++k) \
        acc[ai][bj][m][n] = __builtin_amdgcn_mfma_f32_16x16x32_bf16(Bt[n][k], At[m][k], acc[ai][bj][m][n], 0, 0, 0); __builtin_amdgcn_s_setprio(0); } while (0)
#define PG8_WAIT_V(n) asm volatile("s_waitcnt vmcnt(" #n ")" ::: "memory")
#define PG8_WAIT_L(n) asm volatile("s_waitcnt lgkmcnt(" #n ")" ::: "memory")
#define PG8_BAR __builtin_amdgcn_s_barrier()
#define PG8_SCHED __builtin_amdgcn_sched_barrier(0)
    Unit cur, nxt; int ui = 0;
    if (!S.next(0, cur)) return;
    f32x4 acc[2][2][4][2];
#pragma unroll
    for (int a = 0; a < 2; ++a)
#pragma unroll
        for (int b = 0; b < 2; ++b)
#pragma unroll
            for (int m = 0; m < 4; ++m)
#pragma unroll
                for (int n = 0; n < 2; ++n) acc[a][b][m][n] = (f32x4){0.f, 0.f, 0.f, 0.f};
    bf16x8 At[4][2], B0[2][2], B1[2][2];
    const char* cA = (const char*)g.A + (size_t)cur.pm * tstep; const char* cB = (const char*)g.Bt + (size_t)cur.pn * tstep;
    S.a_ready(cur);
    if constexpr (SP2) {
        PG8_STAGE(PG8_SB(0, 0), cB, voffB); PG8_STAGE(PG8_SB(0, 1), cB + hstep, voffB); PG8_STAGE(PG8_SA(0, 0), cA, voffA); PG8_STAGE(PG8_SA(0, 1), cA + hstep, voffA);
        if (wr == 1) PG8_BAR;
        PG8_WAIT_V(2); PG8_BAR;
        PG8_STAGE(PG8_SB(1, 0), cB + kstep, voffB); PG8_STAGE(PG8_SA(1, 0), cA + kstep, voffA); PG8_STAGE(PG8_SB(1, 1), cB + hstep + kstep, voffB);
        PG8_WAIT_V(6); PG8_BAR;
    } else {
        PG8_STAGE(PG8_SB(0, 0), cB, voffB); PG8_STAGE(PG8_SA(0, 0), cA, voffA); PG8_STAGE(PG8_SB(0, 1), cB + hstep, voffB); PG8_STAGE(PG8_SA(0, 1), cA + hstep, voffA);
        if (wr == 1) PG8_BAR;
        PG8_WAIT_V(4); PG8_BAR;
        PG8_STAGE(PG8_SB(1, 0), cB + kstep, voffB); PG8_STAGE(PG8_SA(1, 0), cA + kstep, voffA); PG8_STAGE(PG8_SB(1, 1), cB + hstep + kstep, voffB);
        PG8_WAIT_V(6); PG8_BAR;
    }
    for (;;) {
        const bool has_next = S.next(ui + 1, nxt);
        const char* nA = has_next ? (const char*)g.A + (size_t)nxt.pm * tstep : cA; const char* nB = has_next ? (const char*)g.Bt + (size_t)nxt.pn * tstep : cB;
        for (int t = 0; t < nt; t += 2) {
            const bool last = (t == nt - 2);
            const char* a1 = cA + (size_t)(t + 1) * kstep;
            const char* a2 = last ? nA : cA + (size_t)(t + 2) * kstep; const char* b2 = last ? nB : cB + (size_t)(t + 2) * kstep;
            const char* a3 = a2 + kstep; const char* b3 = b2 + kstep;
            if (last && has_next) S.a_ready(nxt);
            if constexpr (SP2) {
            PG8_LDB(B0, 0, 0); PG8_LDB(B1, 0, 1); PG8_SCHED; PG8_LDA(At, 0, 0); PG8_STAGE(PG8_SA(1, 1), a1 + hstep, voffA);
            PG8_WAIT_V(8); PG8_WAIT_L(0); PG8_BAR; PG8_MMA(0, 0, At, B0); PG8_MMA(0, 1, At, B1); PG8_BAR; PG8_SCHED;
            PG8_LDA(At, 0, 1); PG8_STAGE(PG8_SB(0, 0), b2, voffB); PG8_STAGE(PG8_SB(0, 1), b2 + hstep, voffB); PG8_STAGE(PG8_SA(0, 0), a2, voffA);
            PG8_WAIT_V(8); PG8_WAIT_L(0); PG8_BAR; PG8_MMA(1, 0, At, B0); PG8_MMA(1, 1, At, B1); PG8_BAR; PG8_SCHED;
            PG8_LDB(B0, 1, 0); PG8_LDB(B1, 1, 1); PG8_SCHED; PG8_LDA(At, 1, 0); PG8_STAGE(PG8_SA(0, 1), a2 + hstep, voffA);
            PG8_WAIT_V(8); PG8_WAIT_L(0); PG8_BAR; PG8_MMA(0, 0, At, B0); PG8_MMA(0, 1, At, B1); PG8_BAR; PG8_SCHED;
            PG8_LDA(At, 1, 1); PG8_STAGE(PG8_SB(1, 0), b3, voffB); PG8_STAGE(PG8_SB(1, 1), b3 + hstep, voffB); PG8_STAGE(PG8_SA(1, 0), a3, voffA);
            PG8_WAIT_V(8); PG8_WAIT_L(0); PG8_BAR; PG8_MMA(1, 0, At, B0); PG8_MMA(1, 1, At, B1); PG8_BAR; PG8_SCHED;
            } else {
            PG8_LDB(B0, 0, 0); PG8_SCHED; PG8_LDA(At, 0, 0); PG8_STAGE(PG8_SA(1, 1), a1 + hstep, voffA);
            PG8_WAIT_L(8); PG8_BAR; PG8_WAIT_L(0); PG8_MMA(0, 0, At, B0); PG8_BAR; PG8_SCHED;
            PG8_LDB(B1, 0, 1); PG8_STAGE(PG8_SB(0, 0), b2, voffB);
            PG8_BAR; PG8_WAIT_L(0); PG8_MMA(0, 1, At, B1); PG8_BAR;
            PG8_LDA(At, 0, 1); PG8_STAGE(PG8_SA(0, 0), a2, voffA);
            PG8_BAR; PG8_WAIT_L(0); PG8_MMA(1, 0, At, B0); PG8_BAR; PG8_SCHED;
            PG8_STAGE(PG8_SB(0, 1), b2 + hstep, voffB);
            PG8_WAIT_V(6); PG8_BAR; PG8_MMA(1, 1, At, B1); PG8_BAR;
            PG8_LDB(B0, 1, 0); PG8_SCHED; PG8_LDA(At, 1, 0); PG8_STAGE(PG8_SA(0, 1), a2 + hstep, voffA);
            PG8_WAIT_L(8); PG8_BAR; PG8_WAIT_L(0); PG8_MMA(0, 0, At, B0); PG8_BAR; PG8_SCHED;
            PG8_LDB(B1, 1, 1); PG8_STAGE(PG8_SB(1, 0), b3, voffB);
            PG8_BAR; PG8_WAIT_L(0); PG8_MMA(0, 1, At, B1); PG8_BAR;
            PG8_LDA(At, 1, 1); PG8_STAGE(PG8_SA(1, 0), a3, voffA);
            PG8_BAR; PG8_WAIT_L(0); PG8_MMA(1, 0, At, B0); PG8_BAR; PG8_SCHED;
            PG8_STAGE(PG8_SB(1, 1), b3 + hstep, voffB);
            PG8_WAIT_V(6); PG8_BAR; PG8_MMA(1, 1, At, B1); PG8_BAR;
            }
        }
        if constexpr (ALIGN_EPI) { if (wr == 0) PG8_BAR; }
        if constexpr (!Epi::AFTER_DRAIN) { E(acc, cur, wr, wc, fr, fq); S.done(cur); }
        if (!has_next) break;
#pragma unroll
        for (int a = 0; a < 2; ++a)
#pragma unroll
            for (int b = 0; b < 2; ++b)
#pragma unroll
                for (int m = 0; m < 4; ++m)
#pragma unroll
                    for (int n = 0; n < 2; ++n) acc[a][b][m][n] = (f32x4){0.f, 0.f, 0.f, 0.f};
        cur = nxt; cA = nA; cB = nB; ++ui;
        if constexpr (ALIGN_EPI) { if (wr == 1) PG8_BAR; }
    }
    PG8_WAIT_V(0);
    if constexpr (!ALIGN_EPI) { if (wr == 0) PG8_BAR; }
    PG8_BAR;
    if constexpr (Epi::AFTER_DRAIN) { E.fused(acc, cur, wr, wc, fr, fq, lds, wid, lane); S.done(cur); }
#undef PG8_SA
#undef PG8_SB
#undef PG8_STAGE
#undef PG8_LDA
#undef PG8_LDB
#undef PG8_MMA
#undef PG8_WAIT_V
#undef PG8_WAIT_L
#undef PG8_BAR
#undef PG8_SCHED
}
}

#define DI __device__ __forceinline__
#define LAS __attribute__((address_space(3)))
typedef unsigned short bf16;
typedef short bf16x8 __attribute__((ext_vector_type(8)));
typedef short s16x4 __attribute__((ext_vector_type(4)));
typedef float f32x4 __attribute__((ext_vector_type(4)));
typedef float f32x16 __attribute__((ext_vector_type(16)));
typedef unsigned u32x4 __attribute__((ext_vector_type(4)));
typedef unsigned u32x2 __attribute__((ext_vector_type(2)));
typedef __bf16 bf16x2_t __attribute__((ext_vector_type(2)));
typedef float f32x2_t __attribute__((ext_vector_type(2)));
typedef LAS unsigned char* ldsp;

DI unsigned pk2(float a, float b) { f32x2_t f = {a, b}; return __builtin_bit_cast(unsigned, __builtin_convertvector(f, bf16x2_t)); }
DI float bflo(unsigned w) { return __uint_as_float(w << 16); }
DI float bfhi(unsigned w) { return __uint_as_float(w & 0xffff0000u); }
DI unsigned short f2bf1(float a) { return (unsigned short)(pk2(a, 0.f) & 0xffffu); }
DI void unpack8(const u32x4 r, float (&f)[8]) { f[0] = bflo(r.x); f[1] = bfhi(r.x); f[2] = bflo(r.y); f[3] = bfhi(r.y); f[4] = bflo(r.z); f[5] = bfhi(r.z); f[6] = bflo(r.w); f[7] = bfhi(r.w); }
DI u32x4 pack8(const float (&f)[8]) { u32x4 r; r.x = pk2(f[0], f[1]); r.y = pk2(f[2], f[3]); r.z = pk2(f[4], f[5]); r.w = pk2(f[6], f[7]); return r; }
DI int opaque_tid() { int t = threadIdx.x; asm volatile("" : "+v"(t)); return t; }
DI float ex2(float x) { return __builtin_amdgcn_exp2f(x); }
DI float gelu_t(float x) { const float u = x * (1.f + 0.044715f * x * x); return x * __builtin_amdgcn_rcpf(1.f + ex2(-2.302208198f * u)); }
DI float silu_f(float x) { return x * __builtin_amdgcn_rcpf(1.f + ex2(-1.4426950409f * x)); }
DI float wave_sum(float v) {
#pragma unroll
    for (int o = 1; o < 64; o <<= 1) v += __shfl_xor(v, o);
    return v;
}
#define LDS_WAIT() asm volatile("s_waitcnt lgkmcnt(0)" ::: "memory")
#define MFMA16(a, b, c) __builtin_amdgcn_mfma_f32_16x16x32_bf16((a), (b), (c), 0, 0, 0)
#define MFMA32(a, b, c) __builtin_amdgcn_mfma_f32_32x32x16_bf16((a), (b), (c), 0, 0, 0)

constexpr int MTOK = 16384, DM = 1024, INW = 3072, DFF = 2816, UPW = 5632, NCTX = 8192;
constexpr float EPS = 1e-6f;
enum { I_XP = 0, I_XS, I_C, I_CK, I_CV, I_SRF, I_SRB, I_CCTX, I_N1, I_WMOD, I_BMOD, I_WIN, I_SGUN, I_SGUW, I_SGUB, I_RLF, I_RLB, I_RETN,
       I_QN, I_KN, I_DLAM, I_DN, I_WOUT, I_N2, I_FUP, I_FCONV, I_FCB, I_FDN, N_IN };
constexpr size_t O_Y = 0, O_CK = 16777216, O_CV = 25165824, O_RF = 33554432, O_RB = 34603008, O_END = 35651584;
constexpr size_t MiB = 1u << 20;
constexpr size_t WS_CTR = 0, WS_TAB = 64 * 1024, WS_MODS = 128 * 1024;
constexpr size_t WS_WIN = 2 * MiB, WS_WOUT = 8 * MiB, WS_WUP = 10 * MiB, WS_WDN = 21 * MiB;
constexpr size_t WS_H = 27 * MiB, WS_Z = 59 * MiB, WS_Q = 155 * MiB, WS_KCTX = 171 * MiB, WS_KSMP = 179 * MiB, WS_VTCTX = 189 * MiB, WS_VTSMP = 197 * MiB, WS_RS = 207 * MiB;
constexpr size_t WS_UP = 59 * MiB, WS_G = 147 * MiB, WS_END = 256 * MiB;
constexpr size_t WS_H2 = 203 * MiB;
constexpr size_t WS_SS = 1 * MiB, WS_SHW = 236 * MiB, WS_ZERO_BYTES = 1 * MiB + 3 * 65536;
constexpr size_t WS_WIN1 = 237 * MiB, WS_WOUT1 = 243 * MiB, WS_WUP1 = 245 * MiB;
constexpr size_t SHW_SET = 9 * 5632;

constexpr int LDS_MAIN = 131072, LDS_BYTES = LDS_MAIN + 1024;
constexpr int NPH = 23;

struct Params { const float* in[N_IN]; float* out; unsigned char* ws; int ph_lo, ph_hi, coop, pad; };

struct EpiResid {
    static constexpr bool PERM = false, AFTER_DRAIN = false;
    const float* x_ctx; const float* x_smp; float* out; const float* gate;
    __device__ __forceinline__ void operator()(const pg8::f32x4 (&acc)[2][2][4][2], const pg8::Unit& u, int wr, int wc, int fr, int fq) const {
        const int pm = u.pm; const int j = pm < 32 ? 0 : 1 + ((pm - 32) >> 2);
        const float* xs = pm < 32 ? x_ctx + (size_t)pm * 256 * DM : x_smp + (size_t)(pm - 32) * 256 * DM;
        float* o = out + (size_t)pm * 256 * DM;
        const int col0 = u.pn * 256 + wc * 32 + 4 * fq;
        pg8::f32x4 gv[2][2];
#pragma unroll
        for (int bj = 0; bj < 2; ++bj)
#pragma unroll
            for (int n = 0; n < 2; ++n) gv[bj][n] = *(const pg8::f32x4*)(gate + (size_t)j * 6144 + col0 + bj * 128 + n * 16);
#pragma unroll
        for (int ai = 0; ai < 2; ++ai)
#pragma unroll
            for (int m = 0; m < 4; ++m) { const size_t roff = (size_t)(ai * 128 + wr * 64 + m * 16 + fr) * DM + col0;
#pragma unroll
                for (int bj = 0; bj < 2; ++bj)
#pragma unroll
                    for (int n = 0; n < 2; ++n) { const size_t off = roff + bj * 128 + n * 16;
                        const pg8::f32x4 xv = *(const pg8::f32x4*)(xs + off); *(pg8::f32x4*)(o + off) = xv + gv[bj][n] * acc[ai][bj][m][n]; } }
    }
};

template <int MODE> struct EpiResidFold {
    static constexpr bool PERM = false, AFTER_DRAIN = false;
    const float* x_ctx; const float* x_smp; float* out; const float* gate; const float* nw; const float* scb; bf16* xp; float* SS;
    __device__ __forceinline__ void operator()(const pg8::f32x4 (&acc)[2][2][4][2], const pg8::Unit& u, int wr, int wc, int fr, int fq) const {
        const int pm = u.pm; const int j = pm < 32 ? 0 : 1 + ((pm - 32) >> 2);
        const float* xs = pm < 32 ? x_ctx + (size_t)pm * 256 * DM : x_smp + (size_t)(pm - 32) * 256 * DM;
        float* o = out + (size_t)pm * 256 * DM; bf16* xq = xp + (size_t)pm * 256 * DM;
        bf16* xb = (bf16*)(out + (pm < 32 ? O_CK + (size_t)(2 * pm + 1) * 131072 : O_CV + (size_t)(2 * (pm - 32) + 1) * 131072));
        const int col0 = u.pn * 256 + wc * 32 + 4 * fq;
#pragma unroll
        for (int ai = 0; ai < 2; ++ai)
#pragma unroll
            for (int m = 0; m < 4; ++m) { const int lrow = ai * 128 + wr * 64 + m * 16 + fr; const size_t roff = (size_t)lrow * DM + col0; float ssq = 0.f;
                pg8::f32x4 xv[2][2], gv[2][2];
#pragma unroll
                for (int bj = 0; bj < 2; ++bj)
#pragma unroll
                    for (int n = 0; n < 2; ++n) gv[bj][n] = *(const pg8::f32x4*)(gate + (size_t)j * 6144 + col0 + bj * 128 + n * 16);
#pragma unroll
                for (int bj = 0; bj < 2; ++bj)
#pragma unroll
                    for (int n = 0; n < 2; ++n) { if (MODE == 2) { const u32x2 r = *(const u32x2*)(xb + roff + bj * 128 + n * 16); xv[bj][n] = (pg8::f32x4){bflo(r.x), bfhi(r.x), bflo(r.y), bfhi(r.y)}; }
                        else xv[bj][n] = *(const pg8::f32x4*)(xs + roff + bj * 128 + n * 16); }
#pragma unroll
                for (int bj = 0; bj < 2; ++bj)
#pragma unroll
                    for (int n = 0; n < 2; ++n) { const size_t off = roff + bj * 128 + n * 16; const int c = col0 + bj * 128 + n * 16;
                        const pg8::f32x4 y = xv[bj][n] + gv[bj][n] * acc[ai][bj][m][n];
                        if (MODE == 1) { u32x2 yb; yb.x = pk2(y[0], y[1]); yb.y = pk2(y[2], y[3]); *(u32x2*)(xb + off) = yb; } else *(pg8::f32x4*)(o + off) = y;
                        ssq += (y[0] * y[0] + y[1] * y[1]) + (y[2] * y[2] + y[3] * y[3]);
                        const pg8::f32x4 av = *(const pg8::f32x4*)(nw + c) * (*(const pg8::f32x4*)(scb + (size_t)j * 6144 + c) + 1.f);
                        const pg8::f32x4 q = y * av; u32x2 w; w.x = pk2(q[0], q[1]); w.y = pk2(q[2], q[3]); *(u32x2*)(xq + off) = w; }
                ssq += __shfl_xor(ssq, 16); ssq += __shfl_xor(ssq, 32);
                if (fq == 0) __hip_atomic_fetch_add(SS + (size_t)pm * 256 + lrow, ssq, __ATOMIC_RELAXED, __HIP_MEMORY_SCOPE_AGENT);
                asm volatile("" ::: "memory"); }
    }
};
struct EpiBf16Fold {
    static constexpr bool PERM = true, AFTER_DRAIN = false;
    bf16* O; int ldc; const float* SS; const float* bias; int N; int pm_off;
    __device__ __forceinline__ void operator()(const pg8::f32x4 (&acc)[2][2][4][2], const pg8::Unit& u, int wr, int wc, int fr, int fq) const {
        const int gpm = u.pm + pm_off; const int j = gpm < 32 ? 0 : 1 + ((gpm - 32) >> 2);
        const int row0 = u.pm * 256 + wr * 64 + fr, col0 = u.pn * 256 + wc * 32 + 8 * fq;
        pg8::f32x4 bv[2][2];
#pragma unroll
        for (int bj = 0; bj < 2; ++bj)
#pragma unroll
            for (int n = 0; n < 2; ++n) bv[bj][n] = *(const pg8::f32x4*)(bias + (size_t)j * N + col0 + bj * 128 + 4 * n);
        float rs[2][4];
#pragma unroll
        for (int ai = 0; ai < 2; ++ai)
#pragma unroll
            for (int m = 0; m < 4; ++m) rs[ai][m] = SS[(size_t)(row0 + ai * 128 + m * 16) + (size_t)pm_off * 256];
#pragma unroll
        for (int ai = 0; ai < 2; ++ai)
#pragma unroll
            for (int m = 0; m < 4; ++m) { const int lrow = row0 + ai * 128 + m * 16; const float rstd = rsqrtf(rs[ai][m] * (1.f / DM) + EPS);
                bf16* rowp = O + (size_t)lrow * ldc + col0;
#pragma unroll
                for (int bj = 0; bj < 2; ++bj) { const pg8::f32x4 v0 = acc[ai][bj][m][0] * rstd + bv[bj][0], v1 = acc[ai][bj][m][1] * rstd + bv[bj][1];
                    u32x4 w; w.x = pk2(v0[0], v0[1]); w.y = pk2(v0[2], v0[3]); w.z = pk2(v1[0], v1[1]); w.w = pk2(v1[2], v1[3]);
                    *(u32x4*)(rowp + bj * 128) = w; } }
    }
};

template <typename T> DI float ld_as_f32(const T* p);
template <> DI float ld_as_f32<float>(const float* p) { return *p; }
template <> DI float ld_as_f32<bf16>(const bf16* p) { return __uint_as_float((unsigned)(*p) << 16); }
template <typename T> DI void tr_item(const T* src, size_t ld_s, bf16* dst, size_t ld_d, LAS float* scr, int lane) {
    if constexpr (sizeof(T) == 4) {
        f32x4 v[8]; const int rr = lane >> 3, c4 = (lane & 7) * 4;
#pragma unroll
        for (int i = 0; i < 8; ++i) v[i] = *(const f32x4*)((const float*)src + (size_t)(8 * i + rr) * ld_s + c4);
#pragma unroll
        for (int i = 0; i < 8; ++i) { LAS float* d = scr + (8 * i + rr) * 33 + c4; d[0] = v[i][0]; d[1] = v[i][1]; d[2] = v[i][2]; d[3] = v[i][3]; }
    } else {
#pragma unroll 8
        for (int i = 0; i < 32; ++i) { const int kk = 2 * i + (lane >> 5); scr[kk * 33 + (lane & 31)] = ld_as_f32<T>(src + (size_t)kk * ld_s + (lane & 31)); }
    }
    LDS_WAIT();
    const int c = lane & 7;
#pragma unroll
    for (int j = 0; j < 4; ++j) { const int n = (lane >> 3) + 8 * j; const LAS float* s = scr + (8 * c) * 33 + n;
        u32x4 o; o.x = pk2(s[0 * 33], s[1 * 33]); o.y = pk2(s[2 * 33], s[3 * 33]); o.z = pk2(s[4 * 33], s[5 * 33]); o.w = pk2(s[6 * 33], s[7 * 33]);
        *(u32x4*)(dst + (size_t)n * ld_d + 8 * c) = o; }
    LDS_WAIT();
}

DI void gemv9_unit(ldsp lds, const float* v0, const float* v1, int vstride, bool act, const float* W, int N, const float* bvec, float* out, int n0, int ncols = 64) {
    LAS float* S = (LAS float*)lds;
    LAS float* RED = (LAS float*)(lds + 9 * 1024 * 4);
    const int tid = opaque_tid();
    for (int i = tid; i < 9 * 1024; i += 512) { const int j = i >> 10, k = i & 1023; const float v = j == 0 ? v0[k] : v1[(size_t)(j - 1) * vstride + k]; S[i] = act ? silu_f(v) : v; }
    __syncthreads();
    const int cq = tid & 15, kg = tid >> 4; const bool act_col = 4 * cq < ncols;
    const float* w = W + ((size_t)kg * 32) * N + n0 + (act_col ? 4 * cq : 0);
    f32x4 acc[9];
#pragma unroll
    for (int j = 0; j < 9; ++j) acc[j] = (f32x4){0.f, 0.f, 0.f, 0.f};
#pragma unroll 1
    for (int k0 = 0; k0 < 32; k0 += 8) {
        f32x4 wv[8];
#pragma unroll
        for (int k = 0; k < 8; ++k) wv[k] = *(const f32x4*)(w + (size_t)(k0 + k) * N);
#pragma unroll
        for (int k = 0; k < 8; ++k)
#pragma unroll
            for (int j = 0; j < 9; ++j) acc[j] += wv[k] * S[j * 1024 + kg * 32 + k0 + k];
    }
#pragma unroll
    for (int j = 0; j < 9; ++j) *(LAS f32x4*)(RED + (kg * 9 + j) * 64 + 4 * cq) = acc[j];
    __syncthreads();
    for (int o = tid; o < 576; o += 512) { const int j = o >> 6, cc = o & 63; if (cc >= ncols) continue; float sm = bvec ? bvec[n0 + cc] : 0.f;
#pragma unroll 8
        for (int g = 0; g < 32; ++g) sm += RED[(g * 9 + j) * 64 + cc];
        out[(size_t)j * N + n0 + cc] = sm; }
    __syncthreads();
}
DI void phase_mods(const Params& P, ldsp lds) {
    float* mods = (float*)(P.ws + WS_MODS);
    for (int u = blockIdx.x; u < 256; u += gridDim.x) { const int l = u / 128, n0 = (u % 128) * 48;
        gemv9_unit(lds, P.in[I_CCTX], P.in[I_C], 1024, true, P.in[I_WMOD] + (size_t)l * 1024 * 6144, 6144, P.in[I_BMOD] + l * 6144, mods + (size_t)l * 9 * 6144, n0, 48); }
}
DI void phase_shw(const Params& P, ldsp lds) {
    const float* mods = (const float*)(P.ws + WS_MODS); float* shw = (float*)(P.ws + WS_SHW);
    for (int u = blockIdx.x; u < 224; u += gridDim.x) {
        if (u < 88) gemv9_unit(lds, mods + 3072, mods + 6144 + 3072, 6144, false, P.in[I_FUP], 5632, nullptr, shw, u * 64);
        else if (u < 136) gemv9_unit(lds, mods + 9 * 6144, mods + 10 * 6144, 6144, false, P.in[I_WIN] + (size_t)1024 * 3072, 3072, nullptr, shw + SHW_SET, (u - 88) * 64);
        else gemv9_unit(lds, mods + 9 * 6144 + 3072, mods + 10 * 6144 + 3072, 6144, false, P.in[I_FUP] + (size_t)1024 * 5632, 5632, nullptr, shw + 2 * SHW_SET, (u - 136) * 64);
    }
}
DI void phase_tables(const Params& P) {
    if (blockIdx.x != 0) return;
    const int tid = opaque_tid();
    float* tab = (float*)(P.ws + WS_TAB);
    for (int i = tid; i < 1024; i += 512) {
        const int pos = i >> 4, fi = i & 15;
        const float inv = exp2f(-(float)fi * (13.287712379549449f / 16.f));
        const float angf = (float)pos * inv;
        double x = (double)angf; const double kk = rint(x * 0.15915494309189535); x -= kk * 6.283185307179586;
        const double x2 = x * x; double ts = x, sn = x, tc = 1.0, cs = 1.0;
#pragma unroll 1
        for (int n = 1; n <= 14; ++n) { ts *= -x2 / (double)((2 * n) * (2 * n + 1)); sn += ts; tc *= -x2 / (double)((2 * n - 1) * (2 * n)); cs += tc; }
        tab[i * 2] = (float)cs; tab[i * 2 + 1] = (float)sn;
    }
}
DI void phase_prep(const Params& P, int l, ldsp lds, int mask, int blk0 = 0, int nblk = 0, int par = -1) {
    const int tid = opaque_tid(), lane = tid & 63, wid = tid >> 6;
    const int gw = ((int)blockIdx.x - blk0) * 8 + wid, NGW = (nblk ? nblk : (int)gridDim.x) * 8;
    LAS float* scr = (LAS float*)(lds + wid * 16384);
    constexpr int I1 = 16 * 96, I2 = 16 * 32, I3 = 16 * 176, I4 = 44 * 32, I5 = 512;
    const float* w_in = P.in[I_WIN] + (size_t)l * 1024 * 3072; const float* w_out = P.in[I_WOUT] + (size_t)l * 1024 * 1024;
    const float* w_up = P.in[I_FUP] + (size_t)l * 1024 * 5632; const float* w_dn = P.in[I_FDN] + (size_t)l * 2816 * 1024;
    bf16* win_t = (bf16*)(P.ws + (l ? WS_WIN1 : WS_WIN)); bf16* wout_t = (bf16*)(P.ws + (l ? WS_WOUT1 : WS_WOUT)); bf16* wup_t = (bf16*)(P.ws + (l ? WS_WUP1 : WS_WUP));
    if (mask & 1) for (int it = gw; it < I1 + I2 + I3; it += NGW) {
        int r = it; if (par >= 0 && ((it / NGW) & 1) != par) continue;
        if (r < I1) { const int kb = r / 96, nb = r % 96; tr_item<float>(w_in + (size_t)(64 * kb) * 3072 + 32 * nb, 3072, win_t + (size_t)(32 * nb) * 1024 + 64 * kb, 1024, scr, lane); continue; } r -= I1;
        if (r < I2) { const int kb = r / 32, nb = r % 32; tr_item<float>(w_out + (size_t)(64 * kb) * 1024 + 32 * nb, 1024, wout_t + (size_t)(32 * nb) * 1024 + 64 * kb, 1024, scr, lane); continue; } r -= I2;
        { const int kb = r / 176, nb = r % 176; tr_item<float>(w_up + (size_t)(64 * kb) * 5632 + 32 * nb, 5632, wup_t + (size_t)(32 * nb) * 1024 + 64 * kb, 1024, scr, lane); }
    }
    if (mask & 2) for (int r = gw; r < I4; r += NGW) { const int kb = r / 32, nb = r % 32; tr_item<float>(w_dn + (size_t)(64 * kb) * 1024 + 32 * nb, 1024, (bf16*)(P.ws + WS_WDN) + (size_t)(32 * nb) * 2816 + 64 * kb, 2816, scr, lane); }
    if (mask & 4) {
        for (int r = gw; r < I5; r += NGW) { const int b = r >> 6, rem = r & 63, keyblk = rem >> 4, cb = rem & 15;
            tr_item<float>(P.in[I_CV] + ((size_t)(b * 2 + l) * 256 + 64 * keyblk) * 512 + 32 * cb, 512, (bf16*)(P.ws + WS_VTSMP) + ((size_t)b * 512 + 32 * cb) * 1280 + 64 * keyblk, 1280, scr, lane); }
        bf16* ksmp = (bf16*)(P.ws + WS_KSMP);
        for (int i = blockIdx.x * 512 + tid; i < 131072; i += gridDim.x * 512) {
            const int e0 = i * 8, b = e0 >> 17, rem = e0 & 131071, key = rem >> 9, col = rem & 511, h = col >> 7, c128 = col & 127;
            const float* src = P.in[I_CK] + ((size_t)(b * 2 + l) * 256 + key) * 512 + col;
            const f32x4 a = *(const f32x4*)src, c = *(const f32x4*)(src + 4);
            u32x4 o; o.x = pk2(a[0], a[1]); o.y = pk2(a[2], a[3]); o.z = pk2(c[0], c[1]); o.w = pk2(c[2], c[3]);
            *(u32x4*)(ksmp + ((size_t)(b * 4 + h) * 1280 + key) * 128 + c128) = o;
        }
    }
}
DI void phase_norm(const Params& P, const float* __restrict__ x_ctx, const float* __restrict__ x_smp, const float* __restrict__ nw, const float* __restrict__ mods_l, int sh_off, int sc_off) {
    const int tid = opaque_tid(), lane = tid & 63, wid = tid >> 6;
    const int gw = blockIdx.x * 8 + wid, NGW = gridDim.x * 8;
    bf16* __restrict__ H = (bf16*)(P.ws + WS_H);
    for (int mb = gw; mb < MTOK; mb += 4 * NGW) {
        f32x4 v[4][4];
#pragma unroll
        for (int r = 0; r < 4; ++r) { const int m = mb + r * NGW;
            if (m < MTOK) { const float* xr = m < NCTX ? x_ctx + (size_t)m * DM : x_smp + (size_t)(m - NCTX) * DM;
#pragma unroll
                for (int q = 0; q < 4; ++q) v[r][q] = *((const f32x4*)xr + lane + 64 * q); } }
#pragma unroll
        for (int r = 0; r < 4; ++r) { const int m = mb + r * NGW;
            if (m < MTOK) {
                const int j = m < NCTX ? 0 : 1 + ((m - NCTX) >> 10);
                const float* md = mods_l + (size_t)j * 6144;
                float ss = 0.f;
#pragma unroll
                for (int q = 0; q < 4; ++q) ss += (v[r][q][0] * v[r][q][0] + v[r][q][1] * v[r][q][1]) + (v[r][q][2] * v[r][q][2] + v[r][q][3] * v[r][q][3]);
                const float rstd = rsqrtf(wave_sum(ss) * (1.f / DM) + EPS);
#pragma unroll
                for (int q = 0; q < 4; ++q) { const int col = 4 * (lane + 64 * q);
                    const f32x4 w = *(const f32x4*)(nw + col), sc = *(const f32x4*)(md + sc_off + col), sh = *(const f32x4*)(md + sh_off + col);
                    const f32x4 y = (v[r][q] * rstd) * w * (sc + 1.f) + sh;
                    u32x2 o; o.x = pk2(y[0], y[1]); o.y = pk2(y[2], y[3]);
                    *(u32x2*)(H + (size_t)m * DM + col) = o; } } }
    }
}
DI int next_unit(unsigned* ctr, ldsp lds) {
    LAS int* slot = (LAS int*)(lds + LDS_MAIN);
    __syncthreads();
    if (opaque_tid() == 0) *slot = (int)atomicAdd(ctr, 1u);
    __syncthreads();
    return *slot;
}
DI void sgu_unit(const Params& P, int l, int ck, ldsp lds, int gh) {
    const int tid = opaque_tid(), lane = tid & 63, wid = tid >> 6, fr = lane & 15, fq = lane >> 4;
    const bf16* Z = (const bf16*)(P.ws + WS_Z); bf16* YC = (bf16*)(P.ws + WS_H);
    const size_t m0 = (size_t)ck * 128;
    ldsp VnT = lds; ldsp WsL = lds + 256 * 272;
    const float* gn = P.in[I_SGUN] + l * 256;
    {   const int cc = tid & 31, r0 = tid >> 5;
        float gnv[8];
#pragma unroll
        for (int e = 0; e < 8; ++e) gnv[e] = gn[8 * cc + e];
        u32x4 raws[8];
#pragma unroll
        for (int i = 0; i < 8; ++i) raws[i] = *(const u32x4*)(Z + (m0 + r0 + 16 * i) * INW + 256 + 8 * cc);
#pragma unroll
        for (int i = 0; i < 8; ++i) { const int q = r0 + 16 * i;
            const u32x4 raw = raws[i];
            float f[8]; unpack8(raw, f); float ss = 0.f;
#pragma unroll
            for (int e = 0; e < 8; ++e) { f[e] = gelu_t(f[e]); ss += f[e] * f[e]; }
            ss += __shfl_xor(ss, 1); ss += __shfl_xor(ss, 2); ss += __shfl_xor(ss, 4); ss += __shfl_xor(ss, 8); ss += __shfl_xor(ss, 16);
            const float rstd = rsqrtf(ss * (1.f / 256.f) + EPS);
            if ((cc >> 4) == gh) {
#pragma unroll
                for (int e = 0; e < 8; ++e) *(LAS bf16*)(VnT + (8 * cc + e) * 272 + q * 2) = f2bf1(f[e] * rstd * gnv[e]); }
        }
    }
    f32x4 wpre[8];
    {   const f32x4* ws_g = (const f32x4*)(P.in[I_SGUW] + ((size_t)(l * 4 + 2 * gh) * 128) * 128);
#pragma unroll
        for (int i = 0; i < 8; ++i) wpre[i] = ws_g[tid + 512 * i]; }
    for (int g = 2 * gh; g < 2 * gh + 2; ++g) {
#pragma unroll
        for (int i = 0; i < 8; ++i) { const int idx = tid + 512 * i, p = idx >> 5, q4 = idx & 31;
            u32x2 o; o.x = pk2(wpre[i][0], wpre[i][1]); o.y = pk2(wpre[i][2], wpre[i][3]);
            *(LAS u32x2*)(WsL + p * 272 + q4 * 8) = o; }
        __syncthreads();
        if (g < 2 * gh + 1) { const f32x4* ws_g = (const f32x4*)(P.in[I_SGUW] + ((size_t)(l * 4 + g + 1) * 128) * 128);
#pragma unroll
            for (int i = 0; i < 8; ++i) wpre[i] = ws_g[tid + 512 * i]; }
        const int p = 16 * wid + fr; const float bias = P.in[I_SGUB][(l * 4 + g) * 128 + p];
        u32x2 zu[4];
#pragma unroll
        for (int mi = 0; mi < 4; ++mi) zu[mi] = *(const u32x2*)(Z + (m0 + p) * INW + 64 * g + 16 * mi + 4 * fq);
        f32x4 acc[4];
#pragma unroll
        for (int mi = 0; mi < 4; ++mi) acc[mi] = (f32x4){0.f, 0.f, 0.f, 0.f};
#pragma unroll
        for (int ks = 0; ks < 4; ++ks) { const bf16x8 bw = *(const LAS bf16x8*)(WsL + (16 * wid + fr) * 272 + (32 * ks + 8 * fq) * 2);
#pragma unroll
            for (int mi = 0; mi < 4; ++mi) { const bf16x8 av = *(const LAS bf16x8*)(VnT + (64 * g + 16 * mi + fr) * 272 + (32 * ks + 8 * fq) * 2); acc[mi] = MFMA16(av, bw, acc[mi]); } }
#pragma unroll
        for (int mi = 0; mi < 4; ++mi) { const int c0 = 64 * g + 16 * mi + 4 * fq;
            const float y0 = gelu_t(bflo(zu[mi].x)) * (acc[mi][0] + bias), y1 = gelu_t(bfhi(zu[mi].x)) * (acc[mi][1] + bias), y2 = gelu_t(bflo(zu[mi].y)) * (acc[mi][2] + bias), y3 = gelu_t(bfhi(zu[mi].y)) * (acc[mi][3] + bias);
            u32x2 o; o.x = pk2(y0, y1); o.y = pk2(y2, y3);
            *(u32x2*)(YC + (m0 + p) * DM + c0) = o; }
        __syncthreads();
    }
}
DI float log2_sigmoid(float x) { return -log1pf(__expf(-x)) * 1.4426950408889634f; }
DI void rets_unit(const Params& P, int l, int ru, ldsp lds) {
    const int tid = opaque_tid(), lane = tid & 63, wid = tid >> 6, fr = lane & 15, fq = lane >> 4;
    const bf16* Z = (const bf16*)(P.ws + WS_Z); float* RS = (float*)(P.ws + WS_RS);
    const int gck = ru >> 2, h = ru & 3; const size_t m0 = (size_t)gck * 128;
    const float lgf = log2_sigmoid(P.in[I_RLF][l * 4 + h]), lgb = log2_sigmoid(P.in[I_RLB][l * 4 + h]);
    ldsp KfT = lds, KbT = lds + 17408, VT = lds + 34816;
    {   const int cc = tid & 7, pr = tid >> 3;
#pragma unroll
        for (int i = 0; i < 2; ++i) { const int p = pr + 64 * i;
            const u32x4 kr = *(const u32x4*)(Z + (m0 + p) * INW + 768 + 64 * h + 8 * cc), vr = *(const u32x4*)(Z + (m0 + p) * INW + 1024 + 64 * h + 8 * cc);
            float kf[8], vf[8]; unpack8(kr, kf); unpack8(vr, vf);
            const float df = ex2((float)(127 - p) * lgf) * 0.125f, db = ex2((float)p * lgb) * 0.125f;
#pragma unroll
            for (int e = 0; e < 8; ++e) { const int d = 8 * cc + e;
                const int ps = (p ^ ((cc & 3) << 3)) * 2;
                *(LAS bf16*)(KfT + d * 272 + ps) = f2bf1(kf[e] * df); *(LAS bf16*)(KbT + d * 272 + ps) = f2bf1(kf[e] * db); *(LAS bf16*)(VT + d * 272 + ps) = f2bf1(vf[e]); } }
    }
    __syncthreads();
    const int dir = wid >> 2, dblk = wid & 3; ldsp KT = dir ? KbT : KfT;
    f32x4 acc[4];
#pragma unroll
    for (int mi = 0; mi < 4; ++mi) acc[mi] = (f32x4){0.f, 0.f, 0.f, 0.f};
#pragma unroll
    for (int ks = 0; ks < 4; ++ks) { const bf16x8 bk = *(const LAS bf16x8*)(KT + (16 * dblk + fr) * 272 + (32 * ks + 8 * (fq ^ ((2 * dblk + (fr >> 3)) & 3))) * 2);
#pragma unroll
        for (int mi = 0; mi < 4; ++mi) { const bf16x8 av = *(const LAS bf16x8*)(VT + (16 * mi + fr) * 272 + (32 * ks + 8 * (fq ^ ((2 * mi + (fr >> 3)) & 3))) * 2); acc[mi] = MFMA16(av, bk, acc[mi]); } }
    float* dst = RS + ((size_t)ru * 2 + dir) * 4096 + (16 * dblk + fr) * 64;
#pragma unroll
    for (int mi = 0; mi < 4; ++mi) *(f32x4*)(dst + 16 * mi + 4 * fq) = acc[mi];
}
DI void reto_unit(const Params& P, int l, int ru, ldsp lds) {
    const int tid = opaque_tid(), lane = tid & 63, wid = tid >> 6, fr = lane & 15, fq = lane >> 4;
    const bf16* Z = (const bf16*)(P.ws + WS_Z); const float* RS = (const float*)(P.ws + WS_RS); bf16* YC = (bf16*)(P.ws + WS_H);
    const int gck = ru >> 2, h = ru & 3; const size_t m0 = (size_t)gck * 128;
    const bool ctx = gck < 64;
    const int b = ctx ? (gck >> 1) : ((gck - 64) >> 3), n = ctx ? (gck & 1) : ((gck - 64) & 7), N = ctx ? 2 : 8;
    const float lgf = log2_sigmoid(P.in[I_RLF][l * 4 + h]), lgb = log2_sigmoid(P.in[I_RLB][l * 4 + h]);
    const float Gf = ex2(128.f * lgf), Gb = ex2(128.f * lgb);
    ldsp QL = lds, KL = lds + 18432, VT = lds + 36864, RfT = lds + 54272, RbT = lds + 63488;
    u32x4 qkv[2][3];
    {   const int cc = tid & 7, pr = tid >> 3;
#pragma unroll
        for (int i = 0; i < 2; ++i) { const bf16* zr = Z + (m0 + pr + 64 * i) * INW + 64 * h + 8 * cc; qkv[i][0] = *(const u32x4*)(zr + 512); qkv[i][1] = *(const u32x4*)(zr + 768); qkv[i][2] = *(const u32x4*)(zr + 1024); } }
    {
        const int d = tid >> 3, e0 = (tid & 7) * 8;
        float rf[8], rb[8];
        if (ctx) {
#pragma unroll
            for (int e = 0; e < 8; ++e) { rf[e] = 0.f; rb[e] = 0.f; }
        } else {
            const float* sf = P.in[I_SRF] + ((size_t)((b * 2 + l) * 4 + h)) * 4096 + d * 64 + e0; const float* sb = P.in[I_SRB] + ((size_t)((b * 2 + l) * 4 + h)) * 4096 + d * 64 + e0;
#pragma unroll
            for (int e = 0; e < 8; ++e) { rf[e] = sf[e]; rb[e] = sb[e]; }
        }
        {   f32x4 sv[7][2];
#pragma unroll
            for (int m = 0; m < 7; ++m) if (m < n) { const float* s = RS + ((size_t)(((gck - n + m) << 2) | h) * 2 + 0) * 4096 + d * 64 + e0; sv[m][0] = *(const f32x4*)s; sv[m][1] = *(const f32x4*)(s + 4); }
#pragma unroll
            for (int m = 0; m < 7; ++m) if (m < n) {
#pragma unroll
                for (int e = 0; e < 8; ++e) rf[e] = rf[e] * Gf + sv[m][e >> 2][e & 3]; }
        }
        {   f32x4 sv[7][2];
#pragma unroll
            for (int q = 0; q < 7; ++q) { const int m = N - 1 - q; if (m > n) { const float* s = RS + ((size_t)(((gck - n + m) << 2) | h) * 2 + 1) * 4096 + d * 64 + e0; sv[q][0] = *(const f32x4*)s; sv[q][1] = *(const f32x4*)(s + 4); } }
#pragma unroll
            for (int q = 0; q < 7; ++q) { const int m = N - 1 - q; if (m > n) {
#pragma unroll
                for (int e = 0; e < 8; ++e) rb[e] = rb[e] * Gb + sv[q][e >> 2][e & 3]; } }
        }
#pragma unroll
        for (int e = 0; e < 8; ++e) { *(LAS bf16*)(RfT + (e0 + e) * 144 + d * 2) = f2bf1(rf[e]); *(LAS bf16*)(RbT + (e0 + e) * 144 + d * 2) = f2bf1(rb[e]); }
        if (ctx && n == N - 1) { const float* s = RS + ((size_t)ru * 2 + 0) * 4096 + d * 64 + e0; float* o = P.out + O_RF + ((size_t)((b * 2 + l) * 4 + h)) * 4096 + d * 64 + e0;
#pragma unroll
            for (int e = 0; e < 8; ++e) o[e] = rf[e] * Gf + s[e]; }
        if (ctx && n == 0) { const float* s = RS + ((size_t)ru * 2 + 1) * 4096 + d * 64 + e0; float* o = P.out + O_RB + ((size_t)((b * 2 + l) * 4 + h)) * 4096 + d * 64 + e0;
#pragma unroll
            for (int e = 0; e < 8; ++e) o[e] = rb[e] * Gb + s[e]; }
    }
    {   const int cc = tid & 7, pr = tid >> 3;
#pragma unroll
        for (int i = 0; i < 2; ++i) { const int p = pr + 64 * i;
            const u32x4 qr = qkv[i][0], kr = qkv[i][1], vr = qkv[i][2];
            *(LAS u32x4*)(QL + p * 144 + 16 * cc) = qr; *(LAS u32x4*)(KL + p * 144 + 16 * cc) = kr;
            const int ps = (p ^ ((cc & 3) << 3)) * 2;
            *(LAS bf16*)(VT + (8 * cc + 0) * 272 + ps) = (bf16)(vr.x & 0xffffu); *(LAS bf16*)(VT + (8 * cc + 1) * 272 + ps) = (bf16)(vr.x >> 16);
            *(LAS bf16*)(VT + (8 * cc + 2) * 272 + ps) = (bf16)(vr.y & 0xffffu); *(LAS bf16*)(VT + (8 * cc + 3) * 272 + ps) = (bf16)(vr.y >> 16);
            *(LAS bf16*)(VT + (8 * cc + 4) * 272 + ps) = (bf16)(vr.z & 0xffffu); *(LAS bf16*)(VT + (8 * cc + 5) * 272 + ps) = (bf16)(vr.z >> 16);
            *(LAS bf16*)(VT + (8 * cc + 6) * 272 + ps) = (bf16)(vr.w & 0xffffu); *(LAS bf16*)(VT + (8 * cc + 7) * 272 + ps) = (bf16)(vr.w >> 16); }
    }
    __syncthreads();
    bf16x8 qfr[2];
#pragma unroll
    for (int ks = 0; ks < 2; ++ks) qfr[ks] = *(const LAS bf16x8*)(QL + (16 * wid + fr) * 144 + (32 * ks + 8 * fq) * 2);
    f32x4 a1[8];
#pragma unroll
    for (int jb = 0; jb < 8; ++jb) { a1[jb] = (f32x4){0.f, 0.f, 0.f, 0.f};
#pragma unroll
        for (int ks = 0; ks < 2; ++ks) { const bf16x8 kf = *(const LAS bf16x8*)(KL + (16 * jb + fr) * 144 + (32 * ks + 8 * fq) * 2); a1[jb] = MFMA16(kf, qfr[ks], a1[jb]); } }
    const int pl = 16 * wid + fr;
#pragma unroll
    for (int jb = 0; jb < 8; ++jb)
#pragma unroll
        for (int r = 0; r < 4; ++r) { const int dl = pl - (16 * jb + 4 * fq + r);
            const float fdl = (float)dl;
            const float D = ex2(fmaxf(fdl, 0.f) * lgf + fmaxf(-fdl, 0.f) * lgb) + fmaxf(1.f - fabsf(fdl), 0.f);
            a1[jb][r] *= D * 0.125f; }
    f32x4 a2[4], aF[4], aB[4];
#pragma unroll
    for (int eb = 0; eb < 4; ++eb) { a2[eb] = (f32x4){0.f, 0.f, 0.f, 0.f}; aF[eb] = a2[eb]; aB[eb] = a2[eb]; }
#pragma unroll
    for (int k2 = 0; k2 < 4; ++k2) {
        u32x4 pw; pw.x = pk2(a1[2 * k2][0], a1[2 * k2][1]); pw.y = pk2(a1[2 * k2][2], a1[2 * k2][3]); pw.z = pk2(a1[2 * k2 + 1][0], a1[2 * k2 + 1][1]); pw.w = pk2(a1[2 * k2 + 1][2], a1[2 * k2 + 1][3]);
        const bf16x8 pb = __builtin_bit_cast(bf16x8, pw);
#pragma unroll
        for (int eb = 0; eb < 4; ++eb) { const int gx = ((2 * eb + (fr >> 3)) & 3) << 3; const s16x4 lo = *(const LAS s16x4*)(VT + (16 * eb + fr) * 272 + (32 * k2 + ((4 * fq) ^ gx)) * 2), hi = *(const LAS s16x4*)(VT + (16 * eb + fr) * 272 + (32 * k2 + ((16 + 4 * fq) ^ gx)) * 2);
            const bf16x8 va = __builtin_shufflevector(lo, hi, 0, 1, 2, 3, 4, 5, 6, 7); a2[eb] = MFMA16(va, pb, a2[eb]); }
    }
#pragma unroll
    for (int ks = 0; ks < 2; ++ks)
#pragma unroll
        for (int eb = 0; eb < 4; ++eb) { const bf16x8 rfv = *(const LAS bf16x8*)(RfT + (16 * eb + fr) * 144 + (32 * ks + 8 * fq) * 2), rbv = *(const LAS bf16x8*)(RbT + (16 * eb + fr) * 144 + (32 * ks + 8 * fq) * 2);
            aF[eb] = MFMA16(rfv, qfr[ks], aF[eb]); aB[eb] = MFMA16(rbv, qfr[ks], aB[eb]); }
    const float qdf = ex2((float)(pl + 1) * lgf), qdb = ex2((float)(128 - pl) * lgb);
    float ss = 0.f;
#pragma unroll
    for (int eb = 0; eb < 4; ++eb) { a2[eb] = a2[eb] + aF[eb] * qdf + aB[eb] * qdb; ss += (a2[eb][0] * a2[eb][0] + a2[eb][1] * a2[eb][1]) + (a2[eb][2] * a2[eb][2] + a2[eb][3] * a2[eb][3]); }
    ss += __shfl_xor(ss, 16); ss += __shfl_xor(ss, 32);
    const float rstd = rsqrtf(ss * (1.f / 64.f) + EPS);
    const float* rn = P.in[I_RETN] + (l * 4 + h) * 64;
#pragma unroll
    for (int eb = 0; eb < 4; ++eb) { const int e0 = 16 * eb + 4 * fq;
        const u32x2 gr = *(const u32x2*)(Z + (m0 + pl) * INW + 1280 + 64 * h + e0); const f32x4 w = *(const f32x4*)(rn + e0);
        const float y0 = a2[eb][0] * rstd * w[0] * silu_f(bflo(gr.x)), y1 = a2[eb][1] * rstd * w[1] * silu_f(bfhi(gr.x)), y2 = a2[eb][2] * rstd * w[2] * silu_f(bflo(gr.y)), y3 = a2[eb][3] * rstd * w[3] * silu_f(bfhi(gr.y));
        u32x2 o; o.x = pk2(y0, y1); o.y = pk2(y2, y3);
        *(u32x2*)(YC + (m0 + pl) * DM + 256 + 64 * h + e0) = o; }
}
DI void cprep_unit(const Params& P, int l, int cu, ldsp lds) {
    const int tid = opaque_tid();
    const bf16* Z = (const bf16*)(P.ws + WS_Z); bf16* Q = (bf16*)(P.ws + WS_Q); const float* tab = (const float*)(P.ws + WS_TAB);
    const int m0 = cu * 64; const bool ctx = m0 < NCTX;
    const int b = ctx ? (m0 >> 8) : ((m0 - NCTX) >> 10), t0 = ctx ? (m0 & 255) : ((m0 - NCTX) & 1023);
    {   const int c = tid & 7, gs = tid >> 3;
        u32x4 raws[16];
#pragma unroll
        for (int i = 0; i < 16; ++i) { const int item = gs + 64 * i, tok = item >> 4, grp = item & 15; raws[i] = *(const u32x4*)(Z + (size_t)(m0 + tok) * INW + 1536 + grp * 64 + 8 * c); }
#pragma unroll
        for (int i = 0; i < 16; ++i) { const int item = gs + 64 * i, tok = item >> 4, grp = item & 15, m = m0 + tok, t = t0 + tok;
            const u32x4 raw = raws[i];
            float f[8]; unpack8(raw, f); float ss = 0.f;
#pragma unroll
            for (int e = 0; e < 8; ++e) ss += f[e] * f[e];
            ss += __shfl_xor(ss, 1); ss += __shfl_xor(ss, 2); ss += __shfl_xor(ss, 4);
            const float rstd = rsqrtf(ss * (1.f / 64.f) + EPS);
            const float* gp = (grp >> 3) ? P.in[I_KN] + l * 64 + 8 * c : P.in[I_QN] + l * 64 + 8 * c;
            float y[8];
#pragma unroll
            for (int e = 0; e < 8; ++e) y[e] = f[e] * rstd * gp[e];
            if (!ctx) { const int pos = (c < 4) ? (t >> 6) : (t & 63); const float* tp = tab + (pos * 16 + (c & 1) * 8) * 2; const bool first = (c & 2) == 0;
#pragma unroll
                for (int e = 0; e < 8; ++e) { const float pr = __shfl_xor(y[e], 2); const float cs = tp[2 * e], sn = tp[2 * e + 1];
                    y[e] = first ? (y[e] * cs - pr * sn) : (pr * sn + y[e] * cs); } }
            if (grp < 8) {
#pragma unroll
                for (int e = 0; e < 8; ++e) y[e] *= 0.18033688011112042f;
                *(u32x4*)(Q + (size_t)m * 512 + grp * 64 + 8 * c) = pack8(y);
            } else { const int g2 = grp - 8, h = g2 >> 1, half = g2 & 1;
                bf16* kd = ctx ? (bf16*)(P.ws + WS_KCTX) + ((size_t)(b * 4 + h) * 256 + t) * 128 + half * 64 + 8 * c : (bf16*)(P.ws + WS_KSMP) + ((size_t)(b * 4 + h) * 1280 + 256 + t) * 128 + half * 64 + 8 * c;
                *(u32x4*)kd = pack8(y);
                if (ctx) { float* ok = P.out + O_CK + ((size_t)(b * 2 + l) * 256 + t) * 512 + g2 * 64 + 8 * c; *(f32x4*)ok = (f32x4){y[0], y[1], y[2], y[3]}; *(f32x4*)(ok + 4) = (f32x4){y[4], y[5], y[6], y[7]}; } }
        }
    }
    ldsp VL = lds;
    u32x4 vraws[8];
#pragma unroll
    for (int i = 0; i < 8; ++i) { const int id = tid + 512 * i, tok = id >> 6, cc = id & 63; vraws[i] = *(const u32x4*)(Z + (size_t)(m0 + tok) * INW + 2560 + 8 * cc); }
#pragma unroll
    for (int i = 0; i < 8; ++i) { const int id = tid + 512 * i, tok = id >> 6, cc = id & 63;
        const u32x4 raw = vraws[i];
        *(LAS u32x4*)(VL + tok * 1040 + 16 * (cc ^ ((tok >> 3) & 7))) = raw;
        if (ctx) { float f[8]; unpack8(raw, f); float* ov = P.out + O_CV + ((size_t)(b * 2 + l) * 256 + t0 + tok) * 512 + 8 * cc; *(f32x4*)ov = (f32x4){f[0], f[1], f[2], f[3]}; *(f32x4*)(ov + 4) = (f32x4){f[4], f[5], f[6], f[7]}; } }
    __syncthreads();
#pragma unroll 2
    for (int i = 0; i < 8; ++i) { const int id = tid + 512 * i, kc = id & 7, col = id >> 3;
        unsigned short v[8];
#pragma unroll
        for (int e = 0; e < 8; ++e) v[e] = *(const LAS bf16*)(VL + (8 * kc + e) * 1040 + 16 * ((col >> 3) ^ kc) + (col & 7) * 2);
        u32x4 o; o.x = v[0] | ((unsigned)v[1] << 16); o.y = v[2] | ((unsigned)v[3] << 16); o.z = v[4] | ((unsigned)v[5] << 16); o.w = v[6] | ((unsigned)v[7] << 16);
        bf16* vd = ctx ? (bf16*)(P.ws + WS_VTCTX) + ((size_t)b * 512 + col) * 256 + t0 + 8 * kc : (bf16*)(P.ws + WS_VTSMP) + ((size_t)b * 512 + col) * 1280 + 256 + t0 + 8 * kc;
        *(u32x4*)vd = o; }
}
DI void attn_unit(const Params& P, int l, int au, ldsp lds, float lam, float osc) {
    const int tid = opaque_tid(), lane = tid & 63, wid = tid >> 6, r32 = lane & 31, hh = lane >> 5, rg = wid & 3, kg = wid >> 2;
    int b, h, qrow0, np, ldvt; const bf16 *Kb, *VTb;
    if (au < 256) { b = au >> 5; h = (au >> 3) & 3; const int qb = au & 7; qrow0 = NCTX + b * 1024 + qb * 128; np = 10; ldvt = 1280;
        Kb = (const bf16*)(P.ws + WS_KSMP) + ((size_t)(b * 4 + h) * 1280) * 128; VTb = (const bf16*)(P.ws + WS_VTSMP) + ((size_t)(b * 4 + h) * 128) * 1280; }
    else { const int a2 = au - 256; b = a2 >> 3; h = (a2 >> 1) & 3; qrow0 = b * 256 + 128 * (a2 & 1); np = 2; ldvt = 256;
        Kb = (const bf16*)(P.ws + WS_KCTX) + ((size_t)(b * 4 + h) * 256) * 128; VTb = (const bf16*)(P.ws + WS_VTCTX) + ((size_t)(b * 4 + h) * 128) * 256; }
    ldsp KL = lds + kg * 17408; ldsp VL = lds + 34816 + kg * 18432;
    ldsp ST = lds + 73728;
    const bf16* qp = (const bf16*)(P.ws + WS_Q) + (size_t)(qrow0 + 32 * rg + r32) * 512 + h * 128;
    bf16x8 qf[2][4];
#pragma unroll
    for (int i = 0; i < 2; ++i)
#pragma unroll
        for (int s = 0; s < 4; ++s) qf[i][s] = *(const bf16x8*)(qp + i * 64 + 16 * s + 8 * hh);
    u32x4 kreg[4], vreg[4];
    float mm[2] = {-INFINITY, -INFINITY}, ll[2] = {0.f, 0.f};
#define LOADK(tp) do { _Pragma("unroll") for (int _i = 0; _i < 4; ++_i) { const int _id = tid + 512 * _i; kreg[_i] = *(const u32x4*)(Kb + (size_t)(128 * (tp) + (_id >> 4)) * 128 + 8 * (_id & 15)); } } while (0)
#define LOADV(tp) do { _Pragma("unroll") for (int _i = 0; _i < 4; ++_i) { const int _id = tid + 512 * _i; vreg[_i] = *(const u32x4*)(VTb + (size_t)((_id >> 3) & 127) * ldvt + 128 * (tp) + 64 * (_id >> 10) + 8 * (_id & 7)); } } while (0)
#define STOREK() do { _Pragma("unroll") for (int _i = 0; _i < 4; ++_i) { const int _id = tid + 512 * _i; *(LAS u32x4*)(lds + (_id >> 10) * 17408 + ((_id >> 4) & 63) * 272 + 16 * (_id & 15)) = kreg[_i]; } } while (0)
#define STOREV() do { _Pragma("unroll") for (int _i = 0; _i < 4; ++_i) { const int _id = tid + 512 * _i; *(LAS u32x4*)(lds + 34816 + (_id >> 10) * 18432 + ((_id >> 3) & 127) * 144 + 16 * (_id & 7)) = vreg[_i]; } } while (0)
    LOADK(0);
    for (int tp = 0; tp < np; ++tp) {
        __syncthreads(); STOREK(); __syncthreads();
        if (tp + 1 < np) LOADK(tp + 1);
#pragma unroll
        for (int i = 0; i < 2; ++i) {
            f32x16 s0, s1;
#pragma unroll
            for (int r = 0; r < 16; ++r) { s0[r] = 0.f; s1[r] = 0.f; }
#pragma unroll
            for (int s = 0; s < 4; ++s) { const bf16x8 k0 = *(const LAS bf16x8*)(KL + r32 * 272 + (64 * i + 16 * s + 8 * hh) * 2), k1 = *(const LAS bf16x8*)(KL + (32 + r32) * 272 + (64 * i + 16 * s + 8 * hh) * 2);
                s0 = MFMA32(k0, qf[i][s], s0); s1 = MFMA32(k1, qf[i][s], s1); }
            float mx = s0[0];
#pragma unroll
            for (int r = 0; r < 16; ++r) mx = fmaxf(mx, fmaxf(s0[r], s1[r]));
            mx = fmaxf(mx, __shfl_xor(mx, 32));
            const float mn = fmaxf(mm[i], mx); float sum = 0.f;
#pragma unroll
            for (int r = 0; r < 16; ++r) sum += ex2(s0[r] - mn) + ex2(s1[r] - mn);
            ll[i] = ll[i] * ex2(mm[i] - mn) + sum; mm[i] = mn;
        }
    }
    ll[0] += __shfl_xor(ll[0], 32); ll[1] += __shfl_xor(ll[1], 32);
    if (hh == 0) {
#pragma unroll
        for (int i = 0; i < 2; ++i) *(LAS f32x2_t*)(ST + (((kg * 4 + rg) * 2 + i) * 32 + r32) * 8) = (f32x2_t){mm[i], ll[i]};
    }
    LOADK(0); LOADV(0);
    __syncthreads();
    float nb[2];
#pragma unroll
    for (int i = 0; i < 2; ++i) { const f32x2_t o2 = *(const LAS f32x2_t*)(ST + ((((1 - kg) * 4 + rg) * 2 + i) * 32 + r32) * 8);
        const float M = fmaxf(mm[i], o2[0]); const float L = ll[i] * ex2(mm[i] - M) + o2[1] * ex2(o2[0] - M); nb[i] = -(M + __builtin_amdgcn_logf(L)); }
    nb[1] += __builtin_amdgcn_logf(fabsf(lam));
    const float lsgn = lam < 0.f ? -1.f : 1.f;
    f32x16 o[4];
#pragma unroll
    for (int d = 0; d < 4; ++d)
#pragma unroll
        for (int r = 0; r < 16; ++r) o[d][r] = 0.f;
    for (int tp = 0; tp < np; ++tp) {
        __syncthreads(); STOREK(); STOREV(); __syncthreads();
        if (tp + 1 < np) { LOADK(tp + 1); LOADV(tp + 1); }
#pragma unroll
        for (int kb = 0; kb < 2; ++kb) {
            f32x16 pa, s1;
#pragma unroll
            for (int r = 0; r < 16; ++r) { pa[r] = nb[0]; s1[r] = nb[1]; }
#pragma unroll
            for (int s = 0; s < 4; ++s) { const bf16x8 kf = *(const LAS bf16x8*)(KL + (32 * kb + r32) * 272 + (16 * s + 8 * hh) * 2); pa = MFMA32(kf, qf[0][s], pa); }
#pragma unroll
            for (int s = 0; s < 4; ++s) { const bf16x8 kf = *(const LAS bf16x8*)(KL + (32 * kb + r32) * 272 + (64 + 16 * s + 8 * hh) * 2); s1 = MFMA32(kf, qf[1][s], s1); }
#pragma unroll
            for (int r = 0; r < 16; ++r) pa[r] = ex2(pa[r]) - lsgn * ex2(s1[r]);
#pragma unroll
            for (int sp = 0; sp < 2; ++sp) { const int ks = 2 * kb + sp;
                u32x4 pw; pw.x = pk2(pa[8 * sp + 0], pa[8 * sp + 1]); pw.y = pk2(pa[8 * sp + 2], pa[8 * sp + 3]); pw.z = pk2(pa[8 * sp + 4], pa[8 * sp + 5]); pw.w = pk2(pa[8 * sp + 6], pa[8 * sp + 7]);
                const bf16x8 pb = __builtin_bit_cast(bf16x8, pw);
#pragma unroll
                for (int d = 0; d < 4; ++d) { const s16x4 lo = *(const LAS s16x4*)(VL + (32 * d + r32) * 144 + (16 * ks + 4 * hh) * 2), hi = *(const LAS s16x4*)(VL + (32 * d + r32) * 144 + (16 * ks + 8 + 4 * hh) * 2);
                    const bf16x8 va = __builtin_shufflevector(lo, hi, 0, 1, 2, 3, 4, 5, 6, 7); o[d] = MFMA32(va, pb, o[d]); }
            }
        }
    }
#undef LOADK
#undef LOADV
#undef STOREK
#undef STOREV
    __syncthreads();
    ldsp OX = lds + (32 * rg + r32) * 528;
    if (kg == 1) {
#pragma unroll
        for (int d = 0; d < 4; ++d)
#pragma unroll
            for (int g4 = 0; g4 < 4; ++g4) *(LAS f32x4*)(OX + (32 * d + 8 * g4 + 4 * hh) * 4) = (f32x4){o[d][4 * g4 + 0], o[d][4 * g4 + 1], o[d][4 * g4 + 2], o[d][4 * g4 + 3]};
    }
    __syncthreads();
    if (kg == 0) {
        float ss = 0.f;
#pragma unroll
        for (int d = 0; d < 4; ++d)
#pragma unroll
            for (int g4 = 0; g4 < 4; ++g4) { const f32x4 t = *(const LAS f32x4*)(OX + (32 * d + 8 * g4 + 4 * hh) * 4);
#pragma unroll
                for (int e = 0; e < 4; ++e) { o[d][4 * g4 + e] += t[e]; ss += o[d][4 * g4 + e] * o[d][4 * g4 + e]; } }
        ss += __shfl_xor(ss, 32);
        const float rstd = rsqrtf(ss * (1.f / 128.f) + EPS) * osc;
        const float* dn = P.in[I_DN] + l * 128;
        bf16* dst = (bf16*)(P.ws + WS_H) + (size_t)(qrow0 + 32 * rg + r32) * DM + 512 + h * 128;
#pragma unroll
        for (int d = 0; d < 4; ++d)
#pragma unroll
            for (int g4 = 0; g4 < 4; ++g4) { const int d0 = 32 * d + 8 * g4 + 4 * hh; const f32x4 w = *(const f32x4*)(dn + d0);
                u32x2 ov; ov.x = pk2(o[d][4 * g4 + 0] * rstd * w[0], o[d][4 * g4 + 1] * rstd * w[1]); ov.y = pk2(o[d][4 * g4 + 2] * rstd * w[2], o[d][4 * g4 + 3] * rstd * w[3]);
                *(u32x2*)(dst + d0) = ov; }
    }
}
DI void unpack8v(const u32x4 r, f32x2_t (&f)[4]) { f[0] = (f32x2_t){bflo(r.x), bfhi(r.x)}; f[1] = (f32x2_t){bflo(r.y), bfhi(r.y)}; f[2] = (f32x2_t){bflo(r.z), bfhi(r.z)}; f[3] = (f32x2_t){bflo(r.w), bfhi(r.w)}; }
DI void phase_convgate(const Params& P, int l, int hf) {
    const bf16* __restrict__ UP = (const bf16*)(P.ws + WS_UP); bf16* __restrict__ Gb = (bf16*)(P.ws + WS_G) + (size_t)hf * 8192 * DFF;
    const int seqlen = hf ? 1024 : 256;
    const float* __restrict__ cw = P.in[I_FCONV] + (size_t)l * 3 * UPW; const float* __restrict__ cb = P.in[I_FCB] + (size_t)l * UPW;
    const int nitems = 1024 * 352;
    for (int it = blockIdx.x * 512 + opaque_tid(); it < nitems; it += gridDim.x * 512) {
        const int strip = it / 352, ch = it % 352, n0 = 8 * ch, r0 = strip * 8, t0 = r0 % seqlen;
        u32x4 ra[10], rb[10];
        const bool has_prev = t0 != 0, has_next = (t0 + 8) != seqlen;
#pragma unroll
        for (int i = 0; i < 10; ++i) { const int r = r0 - 1 + i; const bool ok = (i == 0) ? has_prev : ((i == 9) ? has_next : true);
            if (ok) { ra[i] = *(const u32x4*)(UP + (size_t)r * UPW + n0); rb[i] = *(const u32x4*)(UP + (size_t)r * UPW + DFF + n0); }
            else { ra[i] = (u32x4){0u, 0u, 0u, 0u}; rb[i] = ra[i]; } }
        f32x2_t wa[3][4], wb[3][4], ba[4], bb[4];
#pragma unroll
        for (int j = 0; j < 3; ++j)
#pragma unroll
            for (int q = 0; q < 4; ++q) { wa[j][q] = *(const f32x2_t*)(cw + j * UPW + n0 + 2 * q); wb[j][q] = *(const f32x2_t*)(cw + j * UPW + DFF + n0 + 2 * q); }
#pragma unroll
        for (int q = 0; q < 4; ++q) { ba[q] = *(const f32x2_t*)(cb + n0 + 2 * q); bb[q] = *(const f32x2_t*)(cb + DFF + n0 + 2 * q); }
        f32x2_t pa[4], pb[4], ca[4], cbv[4], na[4], nb[4];
        unpack8v(ra[0], pa); unpack8v(rb[0], pb); unpack8v(ra[1], ca); unpack8v(rb[1], cbv);
#pragma unroll
        for (int rr = 0; rr < 8; ++rr) { const int r = r0 + rr;
            unpack8v(ra[rr + 2], na); unpack8v(rb[rr + 2], nb);
            u32x4 o; unsigned ow[4];
#pragma unroll
            for (int q = 0; q < 4; ++q) { const f32x2_t ya = wa[0][q] * pa[q] + wa[1][q] * ca[q] + wa[2][q] * na[q] + ba[q], yb = wb[0][q] * pb[q] + wb[1][q] * cbv[q] + wb[2][q] * nb[q] + bb[q];
                const f32x2_t tt = ya * -1.4426950409f; f32x2_t e; e.x = ex2(tt.x); e.y = ex2(tt.y); e = e + 1.f;
                f32x2_t rc; rc.x = __builtin_amdgcn_rcpf(e.x); rc.y = __builtin_amdgcn_rcpf(e.y);
                const f32x2_t g = (ya * rc) * yb; ow[q] = pk2(g.x, g.y);
                pa[q] = ca[q]; pb[q] = cbv[q]; ca[q] = na[q]; cbv[q] = nb[q]; }
            o.x = ow[0]; o.y = ow[1]; o.z = ow[2]; o.w = ow[3];
            *(u32x4*)(Gb + (size_t)r * DFF + n0) = o; }
    }
}

#define XB_TMO      128
#define XB_XCNT(j)  (256  + 64 * (j))
#define XB_XSUB(j)  (1280 + 64 * (j))
#define XB_XGEN(j)  (2304 + 64 * (j))
#define XB_TOP      3328
#define XB_TOPGEN   3392
#define XCD_BAR_WORDS 3456
#define XB_SPIN_CAP (1u << 18)

__device__ __forceinline__ unsigned xb_ld(unsigned* p)              { return __hip_atomic_load(p, __ATOMIC_RELAXED, __HIP_MEMORY_SCOPE_AGENT); }
__device__ __forceinline__ unsigned xb_add(unsigned* p, unsigned v) { return __hip_atomic_fetch_add(p, v, __ATOMIC_RELAXED, __HIP_MEMORY_SCOPE_AGENT); }
__device__ __forceinline__ unsigned xb_xcc_id() { return (unsigned)__builtin_amdgcn_s_getreg((3 << 11) | 20) & 0xFu; }
#define XB_SPIN(cond, bar) do { unsigned _sp = 0; while (cond) { __builtin_amdgcn_s_sleep(1); \
    if ((++_sp & 255u) == 0u) { if (xb_ld(&(bar)[XB_TMO])) break; if (_sp > XB_SPIN_CAP) { atomicAdd(&(bar)[XB_TMO], 1u); break; } } } } while (0)

struct XcdBarrier {
    unsigned* bar; unsigned x;
    volatile LAS unsigned* st;
};

__device__ __forceinline__ XcdBarrier xcd_barrier_post(unsigned* bar, volatile LAS unsigned* st) {
    XcdBarrier b; b.bar = bar; b.x = xb_xcc_id(); b.st = st;
    if (threadIdx.x == 0) (void)xb_add(&bar[XB_XCNT(b.x)], 1u);
    return b;
}
__device__ __forceinline__ void xcd_barrier_complete(unsigned* bar, unsigned x, unsigned& nloc, unsigned& nx) {
    const unsigned G = gridDim.x * gridDim.y * gridDim.z;
    unsigned sum, cnt, mine, sp = 0u;
    for (;;) {
        sum = 0u; cnt = 0u; mine = 0u;
#pragma unroll
        for (unsigned j = 0; j < 16; ++j) { const unsigned c = xb_ld(&bar[XB_XCNT(j)]); sum += c; cnt += (c > 0u) ? 1u : 0u; mine = (j == x) ? c : mine; }
        if (sum == G) break;
        __builtin_amdgcn_s_sleep(1);
        if ((++sp & 255u) == 0u) { if (xb_ld(&bar[XB_TMO])) break; if (sp > XB_SPIN_CAP) { atomicAdd(&bar[XB_TMO], 1u); break; } }
    }
    nloc = mine > 0u ? mine : 1u; nx = cnt > 0u ? cnt : 1u;
}

__device__ __forceinline__ void xcd_barrier(const XcdBarrier& b) {
    asm volatile("s_waitcnt vmcnt(0)" ::: "memory");
    __syncthreads();
    if (threadIdx.x == 0) {
        unsigned* bar = b.bar;
        __builtin_amdgcn_s_waitcnt(0);
        unsigned nloc = b.st[0], nx = b.st[1];
        if (nloc == 0u) { xcd_barrier_complete(bar, b.x, nloc, nx); b.st[0] = nloc; b.st[1] = nx; }
        const unsigned old = xb_add(&bar[XB_XSUB(b.x)], 1u);
        const unsigned gen = old / nloc;
        if (old + 1u == (gen + 1u) * nloc) {
            __builtin_amdgcn_fence(__ATOMIC_RELEASE, "agent");
            asm volatile("s_waitcnt vmcnt(0)" ::: "memory");
            const unsigned og = xb_add(&bar[XB_TOP], 1u);
            const unsigned tg = og / nx;
            if (og + 1u == (tg + 1u) * nx) xb_add(&bar[XB_TOPGEN], 1u);
            else XB_SPIN(xb_ld(&bar[XB_TOPGEN]) == tg, bar);
            __builtin_amdgcn_fence(__ATOMIC_ACQUIRE, "agent");
            xb_add(&bar[XB_XGEN(b.x)], 1u);
            asm volatile("s_waitcnt vmcnt(0)" ::: "memory");
        } else {
            XB_SPIN(xb_ld(&bar[XB_XGEN(b.x)]) == gen, bar);
            __builtin_amdgcn_fence(__ATOMIC_ACQUIRE, "agent");
            asm volatile("s_waitcnt vmcnt(0)" ::: "memory");
        }
    }
    __syncthreads();
}

constexpr size_t WS_BAR = 16 * 1024;
#ifndef EN_G1
#define EN_G1 1
#endif
#ifndef EN_G2
#define EN_G2 1
#endif
#ifndef EN_MA
#define EN_MA 1
#endif
#ifndef EN_MB
#define EN_MB 1
#endif
#ifndef EN_AT
#define EN_AT 1
#endif
#ifndef EN_RO
#define EN_RO 1
#endif
#ifndef EN_CG
#define EN_CG 1
#endif
#ifndef DUP_MASK
#define DUP_MASK 0
#endif
#ifndef DUP_SKIP
#define DUP_SKIP 0
#endif
#define REPS(k) (((DUP_MASK >> (k)) & 1) ? 2 : 1)
#define REPLOOP(k) _Pragma("unroll") for (int rep = 0; rep < REPS(k); ++rep)
#define REPSYNC(k) do { if (rep + 1 < REPS(k)) xcd_barrier(xbar); } while (0)
#define IN(k) (lo <= (k) && (k) < hi)
#ifndef SYNC_REPS
#define SYNC_REPS 1
#endif
#define SEAM(k) do { if (IN(k) && IN((k) + 1)) { for (int _s = 0; _s < SYNC_REPS; ++_s) xcd_barrier(xbar); } } while (0)
template <int L> DI void layer_phases(const Params& P, ldsp lds, const int lo, const int hi, const XcdBarrier& xbar) {
    constexpr int B = 1 + 11 * L;
    const int G = gridDim.x;
    const float* mods_l = (const float*)(P.ws + WS_MODS) + (size_t)L * 9 * 6144;
    const bf16* win_t = (const bf16*)(P.ws + (L ? WS_WIN1 : WS_WIN)); const bf16* wout_t = (const bf16*)(P.ws + (L ? WS_WOUT1 : WS_WOUT)); const bf16* wup_t = (const bf16*)(P.ws + (L ? WS_WUP1 : WS_WUP));
    float* SS2 = (float*)(P.ws + WS_SS) + (L == 0 ? 0 : 2) * 16384; float* SS1 = (float*)(P.ws + WS_SS) + 16384; const float* shw = (const float*)(P.ws + WS_SHW);
    if (L == 0) {
        if (IN(B + 0)) REPLOOP(12) { phase_norm(P, P.in[I_XP], P.in[I_XS], P.in[I_N1], mods_l, 0, 1024); __syncthreads(); phase_shw(P, lds); REPSYNC(12); }
        SEAM(B + 0);
    }
    if (EN_G1 && IN(B + 1)) REPLOOP(1) {
        pg8::Gemm g{(const bf16*)(P.ws + WS_H), win_t, MTOK, INW, DM};
        pg8::StaticOrder S; S.init(MTOK, INW, G, (int)blockIdx.x);
        if (L == 0) { pg8::EpiBf16<0> E{(bf16*)(P.ws + WS_Z), INW, nullptr, 0, 0, 1.f}; pg8::gemm_phase<pg8::EpiBf16<0>, pg8::StaticOrder, true, true>(lds, g, S, E); }
        else { EpiBf16Fold E{(bf16*)(P.ws + WS_Z), INW, SS1, shw + SHW_SET, INW, 0}; pg8::gemm_phase<EpiBf16Fold, pg8::StaticOrder, true, true>(lds, g, S, E); }
        REPSYNC(1);
    }
    SEAM(B + 1);
    if (EN_MA && IN(B + 2)) REPLOOP(2) {
        if (L > 0) phase_prep(P, L, lds, 2 | 4);
        __syncthreads();
        for (int vb = blockIdx.x; vb < 256; vb += G) {
            sgu_unit(P, L, vb >> 1, lds, vb & 1); __syncthreads();
            cprep_unit(P, L, vb, lds); __syncthreads();
            rets_unit(P, L, 2 * vb, lds); __syncthreads(); rets_unit(P, L, 2 * vb + 1, lds); __syncthreads();
        }
        REPSYNC(2);
    }
    SEAM(B + 2);
    if (EN_MB && IN(B + 3)) REPLOOP(3) {
        unsigned* ctr = (unsigned*)(P.ws + WS_CTR) + (B + 3) + 32 * rep;
        const float* dl = P.in[I_DLAM] + L * 256; const int lane = opaque_tid() & 63;
        const float s1 = wave_sum(dl[lane] * dl[64 + lane]), s2 = wave_sum(dl[128 + lane] * dl[192 + lane]);
        const float lam_init = L == 0 ? 0.2f : 0.35550906759f;
        const float lam = expf(s1) - expf(s2) + lam_init;
        if (EN_AT && !(rep == 1 && (DUP_SKIP & 1))) {
#pragma unroll 1
            for (int pass = 0; pass < 2; ++pass)
#pragma unroll 1
                for (int vb = blockIdx.x; vb < 256; vb += G) { const int x = vb & 7, sl = vb >> 3;
                    const int u = pass == 0 ? (4 * x + (sl >> 3)) * 8 + (sl & 7) : 256 + (16 * x + (sl >> 1)) * 2 + (sl & 1);
                    __syncthreads(); attn_unit(P, L, u, lds, lam, 1.f - lam_init); }
        }
        if (EN_RO && !(rep == 1 && (DUP_SKIP & 2))) for (int u = blockIdx.x; u < 512; u += G) { __syncthreads(); reto_unit(P, L, u, lds); }
        REPSYNC(3);
    }
    SEAM(B + 3);
    if (EN_G2 && IN(B + 4)) {
        pg8::Gemm g{(const bf16*)(P.ws + WS_H), wout_t, MTOK, DM, DM};
        EpiResidFold<L == 0 ? 1 : 0> E{L == 0 ? P.in[I_XP] : P.out, L == 0 ? P.in[I_XS] : P.out + (size_t)NCTX * DM, P.out, mods_l + 2048, P.in[I_N2] + L * DM, mods_l + 4096, (bf16*)(P.ws + WS_H2), SS2};
        pg8::StaticOrder S; S.init(MTOK, DM, G, (int)blockIdx.x);
        pg8::gemm_phase<EpiResidFold<L == 0 ? 1 : 0>, pg8::StaticOrder, true, true>(lds, g, S, E);
    }
    SEAM(B + 4);
#pragma unroll
    for (int hf = 0; hf < 2; ++hf) {
        if (EN_G1 && IN(B + 6 + 2 * hf)) REPLOOP(6) {
            pg8::Gemm g{(const bf16*)(P.ws + WS_H2) + (size_t)hf * 8192 * DM, wup_t, 8192, UPW, DM};
            EpiBf16Fold E{(bf16*)(P.ws + WS_UP), UPW, SS2, shw + (L == 0 ? 0 : 2 * SHW_SET), UPW, 32 * hf};
            pg8::StaticOrder S; S.init(8192, UPW, G, (int)blockIdx.x);
            pg8::gemm_phase<EpiBf16Fold, pg8::StaticOrder, true, true>(lds, g, S, E);
            if (L == 0 && rep == 0 && G == 256 && blockIdx.x >= 192) { __syncthreads(); phase_prep(P, 1, lds, 1, 192, 64, hf); }
            REPSYNC(6);
        }
        SEAM(B + 6 + 2 * hf);
        if (EN_CG && IN(B + 7 + 2 * hf)) REPLOOP(7) { phase_convgate(P, L, hf); REPSYNC(7); }
        SEAM(B + 7 + 2 * hf);
    }
    if (EN_G2 && IN(B + 10)) {
        pg8::Gemm g{(const bf16*)(P.ws + WS_G), (const bf16*)(P.ws + WS_WDN), MTOK, DM, DFF};
        pg8::StaticOrder S; S.init(MTOK, DM, G, (int)blockIdx.x);
        if (L == 0) {
            const float* mods_n = (const float*)(P.ws + WS_MODS) + (size_t)9 * 6144;
            EpiResidFold<2> E{P.out, P.out + (size_t)NCTX * DM, P.out, mods_l + 5120, P.in[I_N1] + DM, mods_n + 1024, (bf16*)(P.ws + WS_H), SS1};
            pg8::gemm_phase<EpiResidFold<2>, pg8::StaticOrder, true, true>(lds, g, S, E);
        } else { EpiResid E{P.out, P.out + (size_t)NCTX * DM, P.out, mods_l + 5120}; pg8::gemm_phase<EpiResid, pg8::StaticOrder, true, true>(lds, g, S, E); }
    }
    if (L == 0) SEAM(B + 10);
}
__global__ void __launch_bounds__(512, 2) mk_fwd(Params P) {
    extern __shared__ __attribute__((aligned(16))) unsigned char lds_raw[];
    ldsp lds = (ldsp)lds_raw;
    cg::grid_group grid = cg::this_grid();
    const int lo = P.ph_lo, hi = P.ph_hi;
    if (threadIdx.x < 8) ((LAS unsigned*)(lds + LDS_MAIN))[threadIdx.x] = 0u;
    __syncthreads();
    unsigned* barw = (unsigned*)(P.ws + WS_BAR);
    if (P.coop == 2) grid.sync();
    XcdBarrier xbar; xbar.bar = barw; xbar.x = 0; xbar.st = nullptr;
    if (hi - lo > 1) xbar = xcd_barrier_post(barw, (volatile LAS unsigned*)(lds + LDS_MAIN + 16));
    if (IN(0)) REPLOOP(11) { phase_tables(P); phase_mods(P, lds); __syncthreads(); phase_prep(P, 0, lds, 1 | 2 | 4); if (gridDim.x != 256) phase_prep(P, 1, lds, 1); REPSYNC(11); }
    SEAM(0);
    layer_phases<0>(P, lds, lo, hi, xbar);
    layer_phases<1>(P, lds, lo, hi, xbar);
}
#undef IN
#undef SEAM

extern "C" void kernel_launch(void* const* d_in, const int* in_sizes, int n_in, void* d_out, int out_size, void* d_ws, size_t ws_size, hipStream_t stream) {
    static int grid = 0;
    if (grid == 0) {
        if (n_in != N_IN || (size_t)out_size != O_END || ws_size < WS_END) { fprintf(stderr, "kernel_launch: unexpected sizes n_in %d out %d ws %zu\n", n_in, out_size, ws_size); grid = -1; return; }
        int dev = 0, cus = 0, per_cu = 0;
        if (hipGetDevice(&dev) != hipSuccess || hipDeviceGetAttribute(&cus, hipDeviceAttributeMultiprocessorCount, dev) != hipSuccess) { grid = -1; return; }
        if (hipFuncSetAttribute((const void*)mk_fwd, hipFuncAttributeMaxDynamicSharedMemorySize, LDS_BYTES) != hipSuccess) { fprintf(stderr, "kernel_launch: hipFuncSetAttribute failed\n"); grid = -1; return; }
        if (hipOccupancyMaxActiveBlocksPerMultiprocessor(&per_cu, (const void*)mk_fwd, 512, LDS_BYTES) != hipSuccess || per_cu < 1) { per_cu = 1; (void)hipGetLastError(); }
        grid = cus * 1;
    }
    if (grid < 0) return;
    if (hipMemsetAsync(d_ws, 0, WS_ZERO_BYTES, stream) != hipSuccess) { fprintf(stderr, "kernel_launch: memset failed\n"); return; }
    Params p{};
    for (int i = 0; i < N_IN; ++i) p.in[i] = (const float*)d_in[i];
    p.out = (float*)d_out; p.ws = (unsigned char*)d_ws; p.coop = KL_COOP; p.pad = 0;
#if KL_COOP
    p.ph_lo = 0; p.ph_hi = NPH;
    void* args[] = {&p};
    hipError_t e = hipLaunchCooperativeKernel((const void*)mk_fwd, dim3(grid), dim3(512), args, LDS_BYTES, stream);
    if (e != hipSuccess) fprintf(stderr, "cooperative launch failed: %s (grid %d)\n", hipGetErrorString(e), grid);
#else
    for (int ph = 0; ph < NPH; ++ph) { p.ph_lo = ph; p.ph_hi = ph + 1; hipLaunchKernelGGL(mk_fwd, dim3(grid), dim3(512), LDS_BYTES, stream, p); }
#endif
}
```

```cpp
#include <hip/hip_runtime.h>
#include <hip/hip_cooperative_groups.h>
#include <cstdio>
#include <cstdint>
namespace cg = cooperative_groups;
#ifndef KL_COOP
#define KL_COOP 1
#endif
namespace pg8 {
#define PG8_LAS __attribute__((address_space(3)))
typedef unsigned short bf16_t;
typedef short bf16x8 __attribute__((ext_vector_type(8)));
typedef float f32x4 __attribute__((ext_vector_type(4)));
typedef unsigned u32x4 __attribute__((ext_vector_type(4)));
constexpr int BM = 256, BK = 64, HALF = 128, HTB = HALF * BK * 2  , STAGE_BYTES = 8 * HTB, NXCD = 8, WGM = 8;

__host__ __device__ __forceinline__ int lds_byte(int r, int c) { const int st = (r >> 4) * 2 + (c >> 5), rr = r & 15, cc = c & 31, ob = rr * 64 + cc * 2; return st * 1024 + (ob ^ (((ob >> 9) & 1) << 5)); }
__host__ __device__ __forceinline__ void stage_rc(int b, int& R, int& C) { const int st = b / 1024, sb = b % 1024, swz = sb ^ (((sb >> 9) & 1) << 5); R = (st >> 1) * 16 + swz / 64; C = (st & 1) * 32 + (swz % 64) / 2; }
__host__ __device__ __forceinline__ int perm32(int rho) { const int n = rho >> 4, i = rho & 15; return 8 * (i >> 2) + 4 * n + (i & 3); }

struct Unit { int pm, pn; };
struct Gemm { const bf16_t* A; const bf16_t* Bt; int M, N, K; };

struct StaticOrder {
    int nM, nN, nwg, G, c;
    __host__ __device__ void init(int M, int N, int G_, int c_) { nM = M / BM; nN = N / BM; nwg = nM * nN; G = G_; c = c_; }
    __host__ __device__ bool next(int i, Unit& u) const {
        const long L = (long)i * G + c; if (L >= nwg) return false;
        int wgid = (int)L; { const int q = nwg / NXCD, r = nwg % NXCD, xcd = wgid % NXCD, off = wgid / NXCD; wgid = (xcd < r ? xcd * (q + 1) : r * (q + 1) + (xcd - r) * q) + off; }
        const int nig = WGM * nN, gid = wgid / nig, fm = gid * WGM, gsz = (nM - fm) < WGM ? (nM - fm) : WGM;
        u.pm = fm + ((wgid % nig) % gsz); u.pn = (wgid % nig) / gsz; return true;
    }
    __device__ __forceinline__ void a_ready(const Unit&) const {}
    __device__ __forceinline__ void done(const Unit&) const {}
};

__device__ __forceinline__ unsigned cvt_pk_bf16(float lo, float hi) { unsigned r; asm volatile("v_cvt_pk_bf16_f32 %0, %1, %2" : "=v"(r) : "v"(lo), "v"(hi)); return r; }
typedef float f32x2 __attribute__((ext_vector_type(2)));
__device__ __forceinline__ f32x2 gelu_pk(f32x2 v) {
    const f32x2 av = __builtin_elementwise_abs(v), d = av * 0.2316418882f + 1.0f;
    f32x2 t; t.x = __builtin_amdgcn_rcpf(d.x); t.y = __builtin_amdgcn_rcpf(d.y);
    f32x2 q = t * 0.5307027145f + (-0.7265760135f); q = q * t + 0.7107068705f; q = q * t + (-0.142248368f); q = q * t + 0.127414796f; q = q * t;
    const f32x2 s = (v * v) * (-0.72134752044f);
    f32x2 e; e.x = __builtin_amdgcn_exp2f(s.x); e.y = __builtin_amdgcn_exp2f(s.y);
    const f32x2 m = v * (q * e), r = v - m;
    f32x2 o; o.x = v.x < 0.f ? m.x : r.x; o.y = v.y < 0.f ? m.y : r.y; return o;
}

template <int ACT  > struct EpiBf16 {
    static constexpr bool PERM = true, AFTER_DRAIN = false; static_assert(ACT == 0 || ACT == 1, "EpiBf16: ACT is 0 (none) or 1 (gelu_pk)");
    bf16_t* O; int ldc; const float* bias; int split_cols; size_t split_stride; float scale0;
    __device__ __forceinline__ void operator()(const f32x4 (&acc)[2][2][4][2], const Unit& u, int wr, int wc, int fr, int fq) const {
        const int row0 = u.pm * BM + wr * 64 + fr; int colt = u.pn * BM; bf16_t* base = O;
        float sc = 1.f; if (split_cols) { const int t = colt / split_cols; base += (size_t)t * split_stride; colt -= t * split_cols; if (t == 0) sc = scale0; }
        const int col0 = colt + wc * 32 + 8 * fq, bcol0 = u.pn * BM + wc * 32 + 8 * fq;
        f32x4 bv[2][2];
#pragma unroll
        for (int bj = 0; bj < 2; ++bj)
#pragma unroll
            for (int n = 0; n < 2; ++n) bv[bj][n] = bias ? *(const f32x4*)(bias + bcol0 + bj * HALF + 4 * n) : (f32x4){0.f, 0.f, 0.f, 0.f};
#pragma unroll
        for (int ai = 0; ai < 2; ++ai)
#pragma unroll
            for (int m = 0; m < 4; ++m) { bf16_t* rowp = base + (size_t)(row0 + ai * HALF + m * 16) * ldc + col0;
#pragma unroll
                for (int bj = 0; bj < 2; ++bj) { f32x4 v0 = acc[ai][bj][m][0] + bv[bj][0], v1 = acc[ai][bj][m][1] + bv[bj][1];
                    if (ACT == 1) { f32x2 a = gelu_pk((f32x2){v0[0], v0[1]}), b = gelu_pk((f32x2){v0[2], v0[3]}), c = gelu_pk((f32x2){v1[0], v1[1]}), d = gelu_pk((f32x2){v1[2], v1[3]});
                        v0 = (f32x4){a.x, a.y, b.x, b.y}; v1 = (f32x4){c.x, c.y, d.x, d.y}; }
                    v0 = v0 * sc; v1 = v1 * sc; u32x4 w; w.x = cvt_pk_bf16(v0[0], v0[1]); w.y = cvt_pk_bf16(v0[2], v0[3]); w.z = cvt_pk_bf16(v1[0], v1[1]); w.w = cvt_pk_bf16(v1[2], v1[3]);
                    *(u32x4*)(rowp + bj * HALF) = w; } }
    }
};
template <class Epi, class Sched, bool ALIGN_EPI = false, bool SP2 = false>
__device__ __forceinline__ void gemm_phase(PG8_LAS unsigned char* lds, const Gemm g, const Sched& S, const Epi& E) {
    int tid_ = threadIdx.x; asm volatile("" : "+v"(tid_));
    const int tid = tid_, wid = __builtin_amdgcn_readfirstlane(tid >> 6), lane = tid & 63, wr = wid >> 2, wc = wid & 3, fr = lane & 15, fq = lane >> 4;
    const int K = g.K, nt = K / BK;
    unsigned voffA[2], voffB[2];
#pragma unroll
    for (int i = 0; i < 2; ++i) { int R, C; stage_rc(tid * 16 + i * 8192, R, C); const int Rb = Epi::PERM ? ((R & ~31) + perm32(R & 31)) : R;
        voffA[i] = (unsigned)(R * K + C) * 2u; voffB[i] = (unsigned)(Rb * K + C) * 2u; }
    const size_t kstep = (size_t)(BK * 2);
    const size_t hstep = (size_t)HALF * K * 2;
    const size_t tstep = 2 * hstep;
    const unsigned ldsw = (unsigned)wid * 1024u;
    const int aoff = lds_byte(wr * 64 + fr, fq * 8), boff = lds_byte(wc * 32 + fr, fq * 8);
#define PG8_SA(b, h) (((b) * 2 + (h)) * HTB)
#define PG8_SB(b, h) ((4 + (b) * 2 + (h)) * HTB)
#define PG8_STAGE(bufoff, gbase, voff) do { _Pragma("unroll") for (int _i = 0; _i < 2; ++_i) \
        __builtin_amdgcn_global_load_lds((const unsigned*)((const char*)(gbase) + (voff)[_i]), (PG8_LAS unsigned*)(lds + (bufoff) + ldsw + _i * 8192), 16, 0, 0); } while (0)
#define PG8_LDA(dst, b, h) do { _Pragma("unroll") for (int m = 0; m < 4; ++m) _Pragma("unroll") for (int k = 0; k < 2; ++k) dst[m][k] = *(const PG8_LAS bf16x8*)(lds + PG8_SA(b, h) + aoff + m * 2048 + k * 1024); } while (0)
#define PG8_LDB(dst, b, h) do { _Pragma("unroll") for (int n = 0; n < 2; ++n) _Pragma("unroll") for (int k = 0; k < 2; ++k) dst[n][k] = *(const PG8_LAS bf16x8*)(lds + PG8_SB(b, h) + boff + n * 2048 + k * 1024); } while (0)
#define PG8_MMA(ai, bj, At, Bt) do { __builtin_amdgcn_s_setprio(1); _Pragma("unroll") for (int m = 0; m < 4; ++m) _Pragma("unroll") for (int n = 0; n < 2; ++n) _Pragma("unroll") for (int k = 0; k < 2; ++k) \
        acc[ai][bj][m][n] = __builtin_amdgcn_mfma_f32_16x16x32_bf16(Bt[n][k], At[m][k], acc[ai][bj][m][n], 0, 0, 0); __builtin_amdgcn_s_setprio(0); } while (0)
#define PG8_WAIT_V(n) asm volatile("s_waitcnt vmcnt(" #n ")" ::: "memory")
#define PG8_WAIT_L(n) asm volatile("s_waitcnt lgkmcnt(" #n ")" ::: "memory")
#define PG8_BAR __builtin_amdgcn_s_barrier()
#define PG8_SCHED __builtin_amdgcn_sched_barrier(0)
    Unit cur, nxt; int ui = 0;
    if (!S.next(0, cur)) return;
    f32x4 acc[2][2][4][2];
#pragma unroll
    for (int a = 0; a < 2; ++a)
#pragma unroll
        for (int b = 0; b < 2; ++b)
#pragma unroll
            for (int m = 0; m < 4; ++m)
#pragma unroll
                for (int n = 0; n < 2; ++n) acc[a][b][m][n] = (f32x4){0.f, 0.f, 0.f, 0.f};
    bf16x8 At[4][2], B0[2][2], B1[2][2];
    const char* cA = (const char*)g.A + (size_t)cur.pm * tstep; const char* cB = (const char*)g.Bt + (size_t)cur.pn * tstep;
    S.a_ready(cur);
    if constexpr (SP2) {
        PG8_STAGE(PG8_SB(0, 0), cB, voffB); PG8_STAGE(PG8_SB(0, 1), cB + hstep, voffB); PG8_STAGE(PG8_SA(0, 0), cA, voffA); PG8_STAGE(PG8_SA(0, 1), cA + hstep, voffA);
        if (wr == 1) PG8_BAR;
        PG8_WAIT_V(2); PG8_BAR;
        PG8_STAGE(PG8_SB(1, 0), cB + kstep, voffB); PG8_STAGE(PG8_SA(1, 0), cA + kstep, voffA); PG8_STAGE(PG8_SB(1, 1), cB + hstep + kstep, voffB);
        PG8_WAIT_V(6); PG8_BAR;
    } else {
        PG8_STAGE(PG8_SB(0, 0), cB, voffB); PG8_STAGE(PG8_SA(0, 0), cA, voffA); PG8_STAGE(PG8_SB(0, 1), cB + hstep, voffB); PG8_STAGE(PG8_SA(0, 1), cA + hstep, voffA);
        if (wr == 1) PG8_BAR;
        PG8_WAIT_V(4); PG8_BAR;
        PG8_STAGE(PG8_SB(1, 0), cB + kstep, voffB); PG8_STAGE(PG8_SA(1, 0), cA + kstep, voffA); PG8_STAGE(PG8_SB(1, 1), cB + hstep + kstep, voffB);
        PG8_WAIT_V(6); PG8_BAR;
    }
    for (;;) {
        const bool has_next = S.next(ui + 1, nxt);
        const char* nA = has_next ? (const char*)g.A + (size_t)nxt.pm * tstep : cA; const char* nB = has_next ? (const char*)g.Bt + (size_t)nxt.pn * tstep : cB;
        for (int t = 0; t < nt; t += 2) {
            const bool last = (t == nt - 2);
            const char* a1 = cA + (size_t)(t + 1) * kstep;
            const char* a2 = last ? nA : cA + (size_t)(t + 2) * kstep; const char* b2 = last ? nB : cB + (size_t)(t + 2) * kstep;
            const char* a3 = a2 + kstep; const char* b3 = b2 + kstep;
            if (last && has_next) S.a_ready(nxt);
            if constexpr (SP2) {
            PG8_LDB(B0, 0, 0); PG8_LDB(B1, 0, 1); PG8_SCHED; PG8_LDA(At, 0, 0); PG8_STAGE(PG8_SA(1, 1), a1 + hstep, voffA);
            PG8_WAIT_V(8); PG8_WAIT_L(0); PG8_BAR; PG8_MMA(0, 0, At, B0); PG8_MMA(0, 1, At, B1); PG8_BAR; PG8_SCHED;
            PG8_LDA(At, 0, 1); PG8_STAGE(PG8_SB(0, 0), b2, voffB); PG8_STAGE(PG8_SB(0, 1), b2 + hstep, voffB); PG8_STAGE(PG8_SA(0, 0), a2, voffA);
            PG8_WAIT_V(8); PG8_WAIT_L(0); PG8_BAR; PG8_MMA(1, 0, At, B0); PG8_MMA(1, 1, At, B1); PG8_BAR; PG8_SCHED;
            PG8_LDB(B0, 1, 0); PG8_LDB(B1, 1, 1); PG8_SCHED; PG8_LDA(At, 1, 0); PG8_STAGE(PG8_SA(0, 1), a2 + hstep, voffA);
            PG8_WAIT_V(8); PG8_WAIT_L(0); PG8_BAR; PG8_MMA(0, 0, At, B0); PG8_MMA(0, 1, At, B1); PG8_BAR; PG8_SCHED;
            PG8_LDA(At, 1, 1); PG8_STAGE(PG8_SB(1, 0), b3, voffB); PG8_STAGE(PG8_SB(1, 1), b3 + hstep, voffB); PG8_STAGE(PG8_SA(1, 0), a3, voffA);
            PG8_WAIT_V(8); PG8_WAIT_L(0); PG8_BAR; PG8_MMA(1, 0, At, B0); PG8_MMA(1, 1, At, B1); PG8_BAR; PG8_SCHED;
            } else {
            PG8_LDB(B0, 0, 0); PG8_SCHED; PG8_LDA(At, 0, 0); PG8_STAGE(PG8_SA(1, 1), a1 + hstep, voffA);
            PG8_WAIT_L(8); PG8_BAR; PG8_WAIT_L(0); PG8_MMA(0, 0, At, B0); PG8_BAR; PG8_SCHED;
            PG8_LDB(B1, 0, 1); PG8_STAGE(PG8_SB(0, 0), b2, voffB);
            PG8_BAR; PG8_WAIT_L(0); PG8_MMA(0, 1, At, B1); PG8_BAR;
            PG8_LDA(At, 0, 1); PG8_STAGE(PG8_SA(0, 0), a2, voffA);
            PG8_BAR; PG8_WAIT_L(0); PG8_MMA(1, 0, At, B0); PG8_BAR; PG8_SCHED;
            PG8_STAGE(PG8_SB(0, 1), b2 + hstep, voffB);
            PG8_WAIT_V(6); PG8_BAR; PG8_MMA(1, 1, At, B1); PG8_BAR;
            PG8_LDB(B0, 1, 0); PG8_SCHED; PG8_LDA(At, 1, 0); PG8_STAGE(PG8_SA(0, 1), a2 + hstep, voffA);
            PG8_WAIT_L(8); PG8_BAR; PG8_WAIT_L(0); PG8_MMA(0, 0, At, B0); PG8_BAR; PG8_SCHED;
            PG8_LDB(B1, 1, 1); PG8_STAGE(PG8_SB(1, 0), b3, voffB);
            PG8_BAR; PG8_WAIT_L(0); PG8_MMA(0, 1, At, B1); PG8_BAR;
            PG8_LDA(At, 1, 1); PG8_STAGE(PG8_SA(1, 0), a3, voffA);
            PG8_BAR; PG8_WAIT_L(0); PG8_MMA(1, 0, At, B0); PG8_BAR; PG8_SCHED;
            PG8_STAGE(PG8_SB(1, 1), b3 + hstep, voffB);
            PG8_WAIT_V(6); PG8_BAR; PG8_MMA(1, 1, At, B1); PG8_BAR;
            }
        }
        if constexpr (ALIGN_EPI) { if (wr == 0) PG8_BAR; }
        if constexpr (!Epi::AFTER_DRAIN) { E(acc, cur, wr, wc, fr, fq); S.done(cur); }
        if (!has_next) break;
#pragma unroll
        for (int a = 0; a < 2; ++a)
#pragma unroll
            for (int b = 0; b < 2; ++b)
#pragma unroll
                for (int m = 0; m < 4; ++m)
#pragma unroll
                    for (int n = 0; n < 2; ++n) acc[a][b][m][n] = (f32x4){0.f, 0.f, 0.f, 0.f};
        cur = nxt; cA = nA; cB = nB; ++ui;
        if constexpr (ALIGN_EPI) { if (wr == 1) PG8_BAR; }
    }
    PG8_WAIT_V(0);
    if constexpr (!ALIGN_EPI) { if (wr == 0) PG8_BAR; }
    PG8_BAR;
    if constexpr (Epi::AFTER_DRAIN) { E.fused(acc, cur, wr, wc, fr, fq, lds, wid, lane); S.done(cur); }
#undef PG8_SA
#undef PG8_SB
#undef PG8_STAGE
#undef PG8_LDA
#undef PG8_LDB
#undef PG8_MMA
#undef PG8_WAIT_V
#undef PG8_WAIT_L
#undef PG8_BAR
#undef PG8_SCHED
}
}

#define DI __device__ __forceinline__
#define LAS __attribute__((address_space(3)))
typedef unsigned short bf16;
typedef short bf16x8 __attribute__((ext_vector_type(8)));
typedef short s16x4 __attribute__((ext_vector_type(4)));
typedef float f32x4 __attribute__((ext_vector_type(4)));
typedef float f32x16 __attribute__((ext_vector_type(16)));
typedef unsigned u32x4 __attribute__((ext_vector_type(4)));
typedef unsigned u32x2 __attribute__((ext_vector_type(2)));
typedef __bf16 bf16x2_t __attribute__((ext_vector_type(2)));
typedef float f32x2_t __attribute__((ext_vector_type(2)));
typedef LAS unsigned char* ldsp;

DI unsigned pk2(float a, float b) { f32x2_t f = {a, b}; return __builtin_bit_cast(unsigned, __builtin_convertvector(f, bf16x2_t)); }
DI float bflo(unsigned w) { return __uint_as_float(w << 16); }
DI float bfhi(unsigned w) { return __uint_as_float(w & 0xffff0000u); }
DI unsigned short f2bf1(float a) { return (unsigned short)(pk2(a, 0.f) & 0xffffu); }
DI void unpack8(const u32x4 r, float (&f)[8]) { f[0] = bflo(r.x); f[1] = bfhi(r.x); f[2] = bflo(r.y); f[3] = bfhi(r.y); f[4] = bflo(r.z); f[5] = bfhi(r.z); f[6] = bflo(r.w); f[7] = bfhi(r.w); }
DI u32x4 pack8(const float (&f)[8]) { u32x4 r; r.x = pk2(f[0], f[1]); r.y = pk2(f[2], f[3]); r.z = pk2(f[4], f[5]); r.w = pk2(f[6], f[7]); return r; }
DI int opaque_tid() { int t = threadIdx.x; asm volatile("" : "+v"(t)); return t; }
DI float ex2(float x) { return __builtin_amdgcn_exp2f(x); }
DI float gelu_t(float x) { const float u = x * (1.f + 0.044715f * x * x); return x * __builtin_amdgcn_rcpf(1.f + ex2(-2.302208198f * u)); }
DI float silu_f(float x) { return x * __builtin_amdgcn_rcpf(1.f + ex2(-1.4426950409f * x)); }
DI float wave_sum(float v) {
#pragma unroll
    for (int o = 1; o < 64; o <<= 1) v += __shfl_xor(v, o);
    return v;
}
#define LDS_WAIT() asm volatile("s_waitcnt lgkmcnt(0)" ::: "memory")
#define MFMA16(a, b, c) __builtin_amdgcn_mfma_f32_16x16x32_bf16((a), (b), (c), 0, 0, 0)
#define MFMA32(a, b, c) __builtin_amdgcn_mfma_f32_32x32x16_bf16((a), (b), (c), 0, 0, 0)

constexpr int MTOK = 16384, DM = 1024, INW = 3072, DFF = 2816, UPW = 5632, NCTX = 8192;
constexpr float EPS = 1e-6f;
enum { I_XP = 0, I_XS, I_C, I_CK, I_CV, I_SRF, I_SRB, I_CCTX, I_N1, I_WMOD, I_BMOD, I_WIN, I_SGUN, I_SGUW, I_SGUB, I_RLF, I_RLB, I_RETN,
       I_QN, I_KN, I_DLAM, I_DN, I_WOUT, I_N2, I_FUP, I_FCONV, I_FCB, I_FDN, N_IN };
constexpr size_t O_Y = 0, O_CK = 16777216, O_CV = 25165824, O_RF = 33554432, O_RB = 34603008, O_END = 35651584;
constexpr size_t MiB = 1u << 20;
constexpr size_t WS_CTR = 0, WS_TAB = 64 * 1024, WS_MODS = 128 * 1024;
constexpr size_t WS_WIN = 2 * MiB, WS_WOUT = 8 * MiB, WS_WUP = 10 * MiB, WS_WDN = 21 * MiB;
constexpr size_t WS_H = 27 * MiB, WS_Z = 59 * MiB, WS_Q = 155 * MiB, WS_KCTX = 171 * MiB, WS_KSMP = 179 * MiB, WS_VTCTX = 189 * MiB, WS_VTSMP = 197 * MiB, WS_RS = 207 * MiB;
constexpr size_t WS_UP = 59 * MiB, WS_G = 147 * MiB, WS_END = 256 * MiB;
constexpr size_t WS_H2 = 203 * MiB;
constexpr size_t WS_SS = 1 * MiB, WS_SHW = 236 * MiB, WS_ZERO_BYTES = 1 * MiB + 3 * 65536;
constexpr size_t WS_WIN1 = 237 * MiB, WS_WOUT1 = 243 * MiB, WS_WUP1 = 245 * MiB;
constexpr size_t SHW_SET = 9 * 5632;

constexpr int LDS_MAIN = 131072, LDS_BYTES = LDS_MAIN + 1024;
constexpr int NPH = 23;

struct Params { const float* in[N_IN]; float* out; unsigned char* ws; int ph_lo, ph_hi, coop, pad; };

struct EpiResid {
    static constexpr bool PERM = false, AFTER_DRAIN = false;
    const float* x_ctx; const float* x_smp; float* out; const float* gate;
    __device__ __forceinline__ void operator()(const pg8::f32x4 (&acc)[2][2][4][2], const pg8::Unit& u, int wr, int wc, int fr, int fq) const {
        const int pm = u.pm; const int j = pm < 32 ? 0 : 1 + ((pm - 32) >> 2);
        const float* xs = pm < 32 ? x_ctx + (size_t)pm * 256 * DM : x_smp + (size_t)(pm - 32) * 256 * DM;
        float* o = out + (size_t)pm * 256 * DM;
        const int col0 = u.pn * 256 + wc * 32 + 4 * fq;
        pg8::f32x4 gv[2][2];
#pragma unroll
        for (int bj = 0; bj < 2; ++bj)
#pragma unroll
            for (int n = 0; n < 2; ++n) gv[bj][n] = *(const pg8::f32x4*)(gate + (size_t)j * 6144 + col0 + bj * 128 + n * 16);
#pragma unroll
        for (int ai = 0; ai < 2; ++ai)
#pragma unroll
            for (int m = 0; m < 4; ++m) { const size_t roff = (size_t)(ai * 128 + wr * 64 + m * 16 + fr) * DM + col0;
#pragma unroll
                for (int bj = 0; bj < 2; ++bj)
#pragma unroll
                    for (int n = 0; n < 2; ++n) { const size_t off = roff + bj * 128 + n * 16;
                        const pg8::f32x4 xv = *(const pg8::f32x4*)(xs + off); *(pg8::f32x4*)(o + off) = xv + gv[bj][n] * acc[ai][bj][m][n]; } }
    }
};

template <int MODE> struct EpiResidFold {
    static constexpr bool PERM = false, AFTER_DRAIN = false;
    const float* x_ctx; const float* x_smp; float* out; const float* gate; const float* nw; const float* scb; bf16* xp; float* SS;
    __device__ __forceinline__ void operator()(const pg8::f32x4 (&acc)[2][2][4][2], const pg8::Unit& u, int wr, int wc, int fr, int fq) const {
        const int pm = u.pm; const int j = pm < 32 ? 0 : 1 + ((pm - 32) >> 2);
        const float* xs = pm < 32 ? x_ctx + (size_t)pm * 256 * DM : x_smp + (size_t)(pm - 32) * 256 * DM;
        float* o = out + (size_t)pm * 256 * DM; bf16* xq = xp + (size_t)pm * 256 * DM;
        bf16* xb = (bf16*)(out + (pm < 32 ? O_CK + (size_t)(2 * pm + 1) * 131072 : O_CV + (size_t)(2 * (pm - 32) + 1) * 131072));
        const int col0 = u.pn * 256 + wc * 32 + 4 * fq;
#pragma unroll
        for (int ai = 0; ai < 2; ++ai)
#pragma unroll
            for (int m = 0; m < 4; ++m) { const int lrow = ai * 128 + wr * 64 + m * 16 + fr; const size_t roff = (size_t)lrow * DM + col0; float ssq = 0.f;
                pg8::f32x4 xv[2][2], gv[2][2];
#pragma unroll
                for (int bj = 0; bj < 2; ++bj)
#pragma unroll
                    for (int n = 0; n < 2; ++n) gv[bj][n] = *(const pg8::f32x4*)(gate + (size_t)j * 6144 + col0 + bj * 128 + n * 16);
#pragma unroll
                for (int bj = 0; bj < 2; ++bj)
#pragma unroll
                    for (int n = 0; n < 2; ++n) { if (MODE == 2) { const u32x2 r = *(const u32x2*)(xb + roff + bj * 128 + n * 16); xv[bj][n] = (pg8::f32x4){bflo(r.x), bfhi(r.x), bflo(r.y), bfhi(r.y)}; }
                        else xv[bj][n] = *(const pg8::f32x4*)(xs + roff + bj * 128 + n * 16); }
#pragma unroll
                for (int bj = 0; bj < 2; ++bj)
#pragma unroll
                    for (int n = 0; n < 2; ++n) { const size_t off = roff + bj * 128 + n * 16; const int c = col0 + bj * 128 + n * 16;
                        const pg8::f32x4 y = xv[bj][n] + gv[bj][n] * acc[ai][bj][m][n];
                        if (MODE == 1) { u32x2 yb; yb.x = pk2(y[0], y[1]); yb.y = pk2(y[2], y[3]); *(u32x2*)(xb + off) = yb; } else *(pg8::f32x4*)(o + off) = y;
                        ssq += (y[0] * y[0] + y[1] * y[1]) + (y[2] * y[2] + y[3] * y[3]);
                        const pg8::f32x4 av = *(const pg8::f32x4*)(nw + c) * (*(const pg8::f32x4*)(scb + (size_t)j * 6144 + c) + 1.f);
                        const pg8::f32x4 q = y * av; u32x2 w; w.x = pk2(q[0], q[1]); w.y = pk2(q[2], q[3]); *(u32x2*)(xq + off) = w; }
                ssq += __shfl_xor(ssq, 16); ssq += __shfl_xor(ssq, 32);
                if (fq == 0) __hip_atomic_fetch_add(SS + (size_t)pm * 256 + lrow, ssq, __ATOMIC_RELAXED, __HIP_MEMORY_SCOPE_AGENT);
                asm volatile("" ::: "memory"); }
    }
};
struct EpiBf16Fold {
    static constexpr bool PERM = true, AFTER_DRAIN = false;
    bf16* O; int ldc; const float* SS; const float* bias; int N; int pm_off;
    __device__ __forceinline__ void operator()(const pg8::f32x4 (&acc)[2][2][4][2], const pg8::Unit& u, int wr, int wc, int fr, int fq) const {
        const int gpm = u.pm + pm_off; const int j = gpm < 32 ? 0 : 1 + ((gpm - 32) >> 2);
        const int row0 = u.pm * 256 + wr * 64 + fr, col0 = u.pn * 256 + wc * 32 + 8 * fq;
        pg8::f32x4 bv[2][2];
#pragma unroll
        for (int bj = 0; bj < 2; ++bj)
#pragma unroll
            for (int n = 0; n < 2; ++n) bv[bj][n] = *(const pg8::f32x4*)(bias + (size_t)j * N + col0 + bj * 128 + 4 * n);
        float rs[2][4];
#pragma unroll
        for (int ai = 0; ai < 2; ++ai)
#pragma unroll
            for (int m = 0; m < 4; ++m) rs[ai][m] = SS[(size_t)(row0 + ai * 128 + m * 16) + (size_t)pm_off * 256];
#pragma unroll
        for (int ai = 0; ai < 2; ++ai)
#pragma unroll
            for (int m = 0; m < 4; ++m) { const int lrow = row0 + ai * 128 + m * 16; const float rstd = rsqrtf(rs[ai][m] * (1.f / DM) + EPS);
                bf16* rowp = O + (size_t)lrow * ldc + col0;
#pragma unroll
                for (int bj = 0; bj < 2; ++bj) { const pg8::f32x4 v0 = acc[ai][bj][m][0] * rstd + bv[bj][0], v1 = acc[ai][bj][m][1] * rstd + bv[bj][1];
                    u32x4 w; w.x = pk2(v0[0], v0[1]); w.y = pk2(v0[2], v0[3]); w.z = pk2(v1[0], v1[1]); w.w = pk2(v1[2], v1[3]);
                    *(u32x4*)(rowp + bj * 128) = w; } }
    }
};

template <typename T> DI float ld_as_f32(const T* p);
template <> DI float ld_as_f32<float>(const float* p) { return *p; }
template <> DI float ld_as_f32<bf16>(const bf16* p) { return __uint_as_float((unsigned)(*p) << 16); }
template <typename T> DI void tr_item(const T* src, size_t ld_s, bf16* dst, size_t ld_d, LAS float* scr, int lane) {
    if constexpr (sizeof(T) == 4) {
        f32x4 v[8]; const int rr = lane >> 3, c4 = (lane & 7) * 4;
#pragma unroll
        for (int i = 0; i < 8; ++i) v[i] = *(const f32x4*)((const float*)src + (size_t)(8 * i + rr) * ld_s + c4);
#pragma unroll
        for (int i = 0; i < 8; ++i) { LAS float* d = scr + (8 * i + rr) * 33 + c4; d[0] = v[i][0]; d[1] = v[i][1]; d[2] = v[i][2]; d[3] = v[i][3]; }
    } else {
#pragma unroll 8
        for (int i = 0; i < 32; ++i) { const int kk = 2 * i + (lane >> 5); scr[kk * 33 + (lane & 31)] = ld_as_f32<T>(src + (size_t)kk * ld_s + (lane & 31)); }
    }
    LDS_WAIT();
    const int c = lane & 7;
#pragma unroll
    for (int j = 0; j < 4; ++j) { const int n = (lane >> 3) + 8 * j; const LAS float* s = scr + (8 * c) * 33 + n;
        u32x4 o; o.x = pk2(s[0 * 33], s[1 * 33]); o.y = pk2(s[2 * 33], s[3 * 33]); o.z = pk2(s[4 * 33], s[5 * 33]); o.w = pk2(s[6 * 33], s[7 * 33]);
        *(u32x4*)(dst + (size_t)n * ld_d + 8 * c) = o; }
    LDS_WAIT();
}

DI void gemv9_unit(ldsp lds, const float* v0, const float* v1, int vstride, bool act, const float* W, int N, const float* bvec, float* out, int n0, int ncols = 64) {
    LAS float* S = (LAS float*)lds;
    LAS float* RED = (LAS float*)(lds + 9 * 1024 * 4);
    const int tid = opaque_tid();
    for (int i = tid; i < 9 * 1024; i += 512) { const int j = i >> 10, k = i & 1023; const float v = j == 0 ? v0[k] : v1[(size_t)(j - 1) * vstride + k]; S[i] = act ? silu_f(v) : v; }
    __syncthreads();
    const int cq = tid & 15, kg = tid >> 4; const bool act_col = 4 * cq < ncols;
    const float* w = W + ((size_t)kg * 32) * N + n0 + (act_col ? 4 * cq : 0);
    f32x4 acc[9];
#pragma unroll
    for (int j = 0; j < 9; ++j) acc[j] = (f32x4){0.f, 0.f, 0.f, 0.f};
#pragma unroll 1
    for (int k0 = 0; k0 < 32; k0 += 8) {
        f32x4 wv[8];
#pragma unroll
        for (int k = 0; k < 8; ++k) wv[k] = *(const f32x4*)(w + (size_t)(k0 + k) * N);
#pragma unroll
        for (int k = 0; k < 8; ++k)
#pragma unroll
            for (int j = 0; j < 9; ++j) acc[j] += wv[k] * S[j * 1024 + kg * 32 + k0 + k];
    }
#pragma unroll
    for (int j = 0; j < 9; ++j) *(LAS f32x4*)(RED + (kg * 9 + j) * 64 + 4 * cq) = acc[j];
    __syncthreads();
    for (int o = tid; o < 576; o += 512) { const int j = o >> 6, cc = o & 63; if (cc >= ncols) continue; float sm = bvec ? bvec[n0 + cc] : 0.f;
#pragma unroll 8
        for (int g = 0; g < 32; ++g) sm += RED[(g * 9 + j) * 64 + cc];
        out[(size_t)j * N + n0 + cc] = sm; }
    __syncthreads();
}
DI void phase_mods(const Params& P, ldsp lds) {
    float* mods = (float*)(P.ws + WS_MODS);
    for (int u = blockIdx.x; u < 256; u += gridDim.x) { const int l = u / 128, n0 = (u % 128) * 48;
        gemv9_unit(lds, P.in[I_CCTX], P.in[I_C], 1024, true, P.in[I_WMOD] + (size_t)l * 1024 * 6144, 6144, P.in[I_BMOD] + l * 6144, mods + (size_t)l * 9 * 6144, n0, 48); }
}
DI void phase_shw(const Params& P, ldsp lds) {
    const float* mods = (const float*)(P.ws + WS_MODS); float* shw = (float*)(P.ws + WS_SHW);
    for (int u = blockIdx.x; u < 224; u += gridDim.x) {
        if (u < 88) gemv9_unit(lds, mods + 3072, mods + 6144 + 3072, 6144, false, P.in[I_FUP], 5632, nullptr, shw, u * 64);
        else if (u < 136) gemv9_unit(lds, mods + 9 * 6144, mods + 10 * 6144, 6144, false, P.in[I_WIN] + (size_t)1024 * 3072, 3072, nullptr, shw + SHW_SET, (u - 88) * 64);
        else gemv9_unit(lds, mods + 9 * 6144 + 3072, mods + 10 * 6144 + 3072, 6144, false, P.in[I_FUP] + (size_t)1024 * 5632, 5632, nullptr, shw + 2 * SHW_SET, (u - 136) * 64);
    }
}
DI void phase_tables(const Params& P) {
    if (blockIdx.x != 0) return;
    const int tid = opaque_tid();
    float* tab = (float*)(P.ws + WS_TAB);
    for (int i = tid; i < 1024; i += 512) {
        const int pos = i >> 4, fi = i & 15;
        const float inv = exp2f(-(float)fi * (13.287712379549449f / 16.f));
        const float angf = (float)pos * inv;
        double x = (double)angf; const double kk = rint(x * 0.15915494309189535); x -= kk * 6.283185307179586;
        const double x2 = x * x; double ts = x, sn = x, tc = 1.0, cs = 1.0;
#pragma unroll 1
        for (int n = 1; n <= 14; ++n) { ts *= -x2 / (double)((2 * n) * (2 * n + 1)); sn += ts; tc *= -x2 / (double)((2 * n - 1) * (2 * n)); cs += tc; }
        tab[i * 2] = (float)cs; tab[i * 2 + 1] = (float)sn;
    }
}
DI void phase_prep(const Params& P, int l, ldsp lds, int mask, int blk0 = 0, int nblk = 0, int par = -1) {
    const int tid = opaque_tid(), lane = tid & 63, wid = tid >> 6;
    const int gw = ((int)blockIdx.x - blk0) * 8 + wid, NGW = (nblk ? nblk : (int)gridDim.x) * 8;
    LAS float* scr = (LAS float*)(lds + wid * 16384);
    constexpr int I1 = 16 * 96, I2 = 16 * 32, I3 = 16 * 176, I4 = 44 * 32, I5 = 512;
    const float* w_in = P.in[I_WIN] + (size_t)l * 1024 * 3072; const float* w_out = P.in[I_WOUT] + (size_t)l * 1024 * 1024;
    const float* w_up = P.in[I_FUP] + (size_t)l * 1024 * 5632; const float* w_dn = P.in[I_FDN] + (size_t)l * 2816 * 1024;
    bf16* win_t = (bf16*)(P.ws + (l ? WS_WIN1 : WS_WIN)); bf16* wout_t = (bf16*)(P.ws + (l ? WS_WOUT1 : WS_WOUT)); bf16* wup_t = (bf16*)(P.ws + (l ? WS_WUP1 : WS_WUP));
    if (mask & 1) for (int it = gw; it < I1 + I2 + I3; it += NGW) {
        int r = it; if (par >= 0 && ((it / NGW) & 1) != par) continue;
        if (r < I1) { const int kb = r / 96, nb = r % 96; tr_item<float>(w_in + (size_t)(64 * kb) * 3072 + 32 * nb, 3072, win_t + (size_t)(32 * nb) * 1024 + 64 * kb, 1024, scr, lane); continue; } r -= I1;
        if (r < I2) { const int kb = r / 32, nb = r % 32; tr_item<float>(w_out + (size_t)(64 * kb) * 1024 + 32 * nb, 1024, wout_t + (size_t)(32 * nb) * 1024 + 64 * kb, 1024, scr, lane); continue; } r -= I2;
        { const int kb = r / 176, nb = r % 176; tr_item<float>(w_up + (size_t)(64 * kb) * 5632 + 32 * nb, 5632, wup_t + (size_t)(32 * nb) * 1024 + 64 * kb, 1024, scr, lane); }
    }
    if (mask & 2) for (int r = gw; r < I4; r += NGW) { const int kb = r / 32, nb = r % 32; tr_item<float>(w_dn + (size_t)(64 * kb) * 1024 + 32 * nb, 1024, (bf16*)(P.ws + WS_WDN) + (size_t)(32 * nb) * 2816 + 64 * kb, 2816, scr, lane); }
    if (mask & 4) {
        for (int r = gw; r < I5; r += NGW) { const int b = r >> 6, rem = r & 63, keyblk = rem >> 4, cb = rem & 15;
            tr_item<float>(P.in[I_CV] + ((size_t)(b * 2 + l) * 256 + 64 * keyblk) * 512 + 32 * cb, 512, (bf16*)(P.ws + WS_VTSMP) + ((size_t)b * 512 + 32 * cb) * 1280 + 64 * keyblk, 1280, scr, lane); }
        bf16* ksmp = (bf16*)(P.ws + WS_KSMP);
        for (int i = blockIdx.x * 512 + tid; i < 131072; i += gridDim.x * 512) {
            const int e0 = i * 8, b = e0 >> 17, rem = e0 & 131071, key = rem >> 9, col = rem & 511, h = col >> 7, c128 = col & 127;
            const float* src = P.in[I_CK] + ((size_t)(b * 2 + l) * 256 + key) * 512 + col;
            const f32x4 a = *(const f32x4*)src, c = *(const f32x4*)(src + 4);
            u32x4 o; o.x = pk2(a[0], a[1]); o.y = pk2(a[2], a[3]); o.z = pk2(c[0], c[1]); o.w = pk2(c[2], c[3]);
            *(u32x4*)(ksmp + ((size_t)(b * 4 + h) * 1280 + key) * 128 + c128) = o;
        }
    }
}
DI void phase_norm(const Params& P, const float* __restrict__ x_ctx, const float* __restrict__ x_smp, const float* __restrict__ nw, const float* __restrict__ mods_l, int sh_off, int sc_off) {
    const int tid = opaque_tid(), lane = tid & 63, wid = tid >> 6;
    const int gw = blockIdx.x * 8 + wid, NGW = gridDim.x * 8;
    bf16* __restrict__ H = (bf16*)(P.ws + WS_H);
    for (int mb = gw; mb < MTOK; mb += 4 * NGW) {
        f32x4 v[4][4];
#pragma unroll
        for (int r = 0; r < 4; ++r) { const int m = mb + r * NGW;
            if (m < MTOK) { const float* xr = m < NCTX ? x_ctx + (size_t)m * DM : x_smp + (size_t)(m - NCTX) * DM;
#pragma unroll
                for (int q = 0; q < 4; ++q) v[r][q] = *((const f32x4*)xr + lane + 64 * q); } }
#pragma unroll
        for (int r = 0; r < 4; ++r) { const int m = mb + r * NGW;
            if (m < MTOK) {
                const int j = m < NCTX ? 0 : 1 + ((m - NCTX) >> 10);
                const float* md = mods_l + (size_t)j * 6144;
                float ss = 0.f;
#pragma unroll
                for (int q = 0; q < 4; ++q) ss += (v[r][q][0] * v[r][q][0] + v[r][q][1] * v[r][q][1]) + (v[r][q][2] * v[r][q][2] + v[r][q][3] * v[r][q][3]);
                const float rstd = rsqrtf(wave_sum(ss) * (1.f / DM) + EPS);
#pragma unroll
                for (int q = 0; q < 4; ++q) { const int col = 4 * (lane + 64 * q);
                    const f32x4 w = *(const f32x4*)(nw + col), sc = *(const f32x4*)(md + sc_off + col), sh = *(const f32x4*)(md + sh_off + col);
                    const f32x4 y = (v[r][q] * rstd) * w * (sc + 1.f) + sh;
                    u32x2 o; o.x = pk2(y[0], y[1]); o.y = pk2(y[2], y[3]);
                    *(u32x2*)(H + (size_t)m * DM + col) = o; } } }
    }
}
DI int next_unit(unsigned* ctr, ldsp lds) {
    LAS int* slot = (LAS int*)(lds + LDS_MAIN);
    __syncthreads();
    if (opaque_tid() == 0) *slot = (int)atomicAdd(ctr, 1u);
    __syncthreads();
    return *slot;
}
DI void sgu_unit(const Params& P, int l, int ck, ldsp lds, int gh) {
    const int tid = opaque_tid(), lane = tid & 63, wid = tid >> 6, fr = lane & 15, fq = lane >> 4;
    const bf16* Z = (const bf16*)(P.ws + WS_Z); bf16* YC = (bf16*)(P.ws + WS_H);
    const size_t m0 = (size_t)ck * 128;
    ldsp VnT = lds; ldsp WsL = lds + 256 * 272;
    const float* gn = P.in[I_SGUN] + l * 256;
    {   const int cc = tid & 31, r0 = tid >> 5;
        float gnv[8];
#pragma unroll
        for (int e = 0; e < 8; ++e) gnv[e] = gn[8 * cc + e];
        u32x4 raws[8];
#pragma unroll
        for (int i = 0; i < 8; ++i) raws[i] = *(const u32x4*)(Z + (m0 + r0 + 16 * i) * INW + 256 + 8 * cc);
#pragma unroll
        for (int i = 0; i < 8; ++i) { const int q = r0 + 16 * i;
            const u32x4 raw = raws[i];
            float f[8]; unpack8(raw, f); float ss = 0.f;
#pragma unroll
            for (int e = 0; e < 8; ++e) { f[e] = gelu_t(f[e]); ss += f[e] * f[e]; }
            ss += __shfl_xor(ss, 1); ss += __shfl_xor(ss, 2); ss += __shfl_xor(ss, 4); ss += __shfl_xor(ss, 8); ss += __shfl_xor(ss, 16);
            const float rstd = rsqrtf(ss * (1.f / 256.f) + EPS);
            if ((cc >> 4) == gh) {
#pragma unroll
                for (int e = 0; e < 8; ++e) *(LAS bf16*)(VnT + (8 * cc + e) * 272 + (q ^ ((cc & 7) << 3)) * 2) = f2bf1(f[e] * rstd * gnv[e]); }
        }
    }
    f32x4 wpre[8];
    {   const f32x4* ws_g = (const f32x4*)(P.in[I_SGUW] + ((size_t)(l * 4 + 2 * gh) * 128) * 128);
#pragma unroll
        for (int i = 0; i < 8; ++i) wpre[i] = ws_g[tid + 512 * i]; }
    for (int g = 2 * gh; g < 2 * gh + 2; ++g) {
#pragma unroll
        for (int i = 0; i < 8; ++i) { const int idx = tid + 512 * i, p = idx >> 5, q4 = idx & 31;
            u32x2 o; o.x = pk2(wpre[i][0], wpre[i][1]); o.y = pk2(wpre[i][2], wpre[i][3]);
            *(LAS u32x2*)(WsL + p * 272 + q4 * 8) = o; }
        __syncthreads();
        if (g < 2 * gh + 1) { const f32x4* ws_g = (const f32x4*)(P.in[I_SGUW] + ((size_t)(l * 4 + g + 1) * 128) * 128);
#pragma unroll
            for (int i = 0; i < 8; ++i) wpre[i] = ws_g[tid + 512 * i]; }
        const int p = 16 * wid + fr; const float bias = P.in[I_SGUB][(l * 4 + g) * 128 + p];
        u32x2 zu[4];
#pragma unroll
        for (int mi = 0; mi < 4; ++mi) zu[mi] = *(const u32x2*)(Z + (m0 + p) * INW + 64 * g + 16 * mi + 4 * fq);
        f32x4 acc[4];
#pragma unroll
        for (int mi = 0; mi < 4; ++mi) acc[mi] = (f32x4){0.f, 0.f, 0.f, 0.f};
#pragma unroll
        for (int ks = 0; ks < 4; ++ks) { const bf16x8 bw = *(const LAS bf16x8*)(WsL + (16 * wid + fr) * 272 + (32 * ks + 8 * fq) * 2);
#pragma unroll
            for (int mi = 0; mi < 4; ++mi) { const bf16x8 av = *(const LAS bf16x8*)(VnT + (64 * g + 16 * mi + fr) * 272 + ((32 * ks + 8 * fq) ^ (((2 * mi + (fr >> 3)) & 7) << 3)) * 2); acc[mi] = MFMA16(av, bw, acc[mi]); } }
#pragma unroll
        for (int mi = 0; mi < 4; ++mi) { const int c0 = 64 * g + 16 * mi + 4 * fq;
            const float y0 = gelu_t(bflo(zu[mi].x)) * (acc[mi][0] + bias), y1 = gelu_t(bfhi(zu[mi].x)) * (acc[mi][1] + bias), y2 = gelu_t(bflo(zu[mi].y)) * (acc[mi][2] + bias), y3 = gelu_t(bfhi(zu[mi].y)) * (acc[mi][3] + bias);
            u32x2 o; o.x = pk2(y0, y1); o.y = pk2(y2, y3);
            *(u32x2*)(YC + (m0 + p) * DM + c0) = o; }
        __syncthreads();
    }
}
DI float log2_sigmoid(float x) { return -log1pf(__expf(-x)) * 1.4426950408889634f; }
DI void rets_unit(const Params& P, int l, int ru, ldsp lds) {
    const int tid = opaque_tid(), lane = tid & 63, wid = tid >> 6, fr = lane & 15, fq = lane >> 4;
    const bf16* Z = (const bf16*)(P.ws + WS_Z); float* RS = (float*)(P.ws + WS_RS);
    const int gck = ru >> 2, h = ru & 3; const size_t m0 = (size_t)gck * 128;
    const float lgf = log2_sigmoid(P.in[I_RLF][l * 4 + h]), lgb = log2_sigmoid(P.in[I_RLB][l * 4 + h]);
    ldsp KfT = lds, KbT = lds + 17408, VT = lds + 34816;
    {   const int cc = tid & 7, pr = tid >> 3;
#pragma unroll
        for (int i = 0; i < 2; ++i) { const int p = pr + 64 * i;
            const u32x4 kr = *(const u32x4*)(Z + (m0 + p) * INW + 768 + 64 * h + 8 * cc), vr = *(const u32x4*)(Z + (m0 + p) * INW + 1024 + 64 * h + 8 * cc);
            float kf[8], vf[8]; unpack8(kr, kf); unpack8(vr, vf);
            const float df = ex2((float)(127 - p) * lgf) * 0.125f, db = ex2((float)p * lgb) * 0.125f;
#pragma unroll
            for (int e = 0; e < 8; ++e) { const int d = 8 * cc + e;
                const int ps = (p ^ ((cc & 3) << 3)) * 2;
                *(LAS bf16*)(KfT + d * 272 + ps) = f2bf1(kf[e] * df); *(LAS bf16*)(KbT + d * 272 + ps) = f2bf1(kf[e] * db); *(LAS bf16*)(VT + d * 272 + ps) = f2bf1(vf[e]); } }
    }
    __syncthreads();
    const int dir = wid >> 2, dblk = wid & 3; ldsp KT = dir ? KbT : KfT;
    f32x4 acc[4];
#pragma unroll
    for (int mi = 0; mi < 4; ++mi) acc[mi] = (f32x4){0.f, 0.f, 0.f, 0.f};
#pragma unroll
    for (int ks = 0; ks < 4; ++ks) { const bf16x8 bk = *(const LAS bf16x8*)(KT + (16 * dblk + fr) * 272 + (32 * ks + 8 * (fq ^ ((2 * dblk + (fr >> 3)) & 3))) * 2);
#pragma unroll
        for (int mi = 0; mi < 4; ++mi) { const bf16x8 av = *(const LAS bf16x8*)(VT + (16 * mi + fr) * 272 + (32 * ks + 8 * (fq ^ ((2 * mi + (fr >> 3)) & 3))) * 2); acc[mi] = MFMA16(av, bk, acc[mi]); } }
    float* dst = RS + ((size_t)ru * 2 + dir) * 4096 + (16 * dblk + fr) * 64;
#pragma unroll
    for (int mi = 0; mi < 4; ++mi) *(f32x4*)(dst + 16 * mi + 4 * fq) = acc[mi];
}
DI void reto_unit(const Params& P, int l, int ru, ldsp lds) {
    const int tid = opaque_tid(), lane = tid & 63, wid = tid >> 6, fr = lane & 15, fq = lane >> 4;
    const bf16* Z = (const bf16*)(P.ws + WS_Z); const float* RS = (const float*)(P.ws + WS_RS); bf16* YC = (bf16*)(P.ws + WS_H);
    const int gck = ru >> 2, h = ru & 3; const size_t m0 = (size_t)gck * 128;
    const bool ctx = gck < 64;
    const int b = ctx ? (gck >> 1) : ((gck - 64) >> 3), n = ctx ? (gck & 1) : ((gck - 64) & 7), N = ctx ? 2 : 8;
    const float lgf = log2_sigmoid(P.in[I_RLF][l * 4 + h]), lgb = log2_sigmoid(P.in[I_RLB][l * 4 + h]);
    const float Gf = ex2(128.f * lgf), Gb = ex2(128.f * lgb);
    ldsp QL = lds, KL = lds + 18432, VT = lds + 36864, RfT = lds + 54272, RbT = lds + 63488;
    u32x4 qkv[2][3];
    {   const int cc = tid & 7, pr = tid >> 3;
#pragma unroll
        for (int i = 0; i < 2; ++i) { const bf16* zr = Z + (m0 + pr + 64 * i) * INW + 64 * h + 8 * cc; qkv[i][0] = *(const u32x4*)(zr + 512); qkv[i][1] = *(const u32x4*)(zr + 768); qkv[i][2] = *(const u32x4*)(zr + 1024); } }
    {
        const int d = tid >> 3, e0 = (tid & 7) * 8;
        float rf[8], rb[8];
        if (ctx) {
#pragma unroll
            for (int e = 0; e < 8; ++e) { rf[e] = 0.f; rb[e] = 0.f; }
        } else {
            const float* sf = P.in[I_SRF] + ((size_t)((b * 2 + l) * 4 + h)) * 4096 + d * 64 + e0; const float* sb = P.in[I_SRB] + ((size_t)((b * 2 + l) * 4 + h)) * 4096 + d * 64 + e0;
#pragma unroll
            for (int e = 0; e < 8; ++e) { rf[e] = sf[e]; rb[e] = sb[e]; }
        }
        {   f32x4 sv[7][2];
#pragma unroll
            for (int m = 0; m < 7; ++m) if (m < n) { const float* s = RS + ((size_t)(((gck - n + m) << 2) | h) * 2 + 0) * 4096 + d * 64 + e0; sv[m][0] = *(const f32x4*)s; sv[m][1] = *(const f32x4*)(s + 4); }
#pragma unroll
            for (int m = 0; m < 7; ++m) if (m < n) {
#pragma unroll
                for (int e = 0; e < 8; ++e) rf[e] = rf[e] * Gf + sv[m][e >> 2][e & 3]; }
        }
        {   f32x4 sv[7][2];
#pragma unroll
            for (int q = 0; q < 7; ++q) { const int m = N - 1 - q; if (m > n) { const float* s = RS + ((size_t)(((gck - n + m) << 2) | h) * 2 + 1) * 4096 + d * 64 + e0; sv[q][0] = *(const f32x4*)s; sv[q][1] = *(const f32x4*)(s + 4); } }
#pragma unroll
            for (int q = 0; q < 7; ++q) { const int m = N - 1 - q; if (m > n) {
#pragma unroll
                for (int e = 0; e < 8; ++e) rb[e] = rb[e] * Gb + sv[q][e >> 2][e & 3]; } }
        }
#pragma unroll
        for (int e = 0; e < 8; ++e) { *(LAS bf16*)(RfT + (e0 + e) * 144 + d * 2) = f2bf1(rf[e]); *(LAS bf16*)(RbT + (e0 + e) * 144 + d * 2) = f2bf1(rb[e]); }
        if (ctx && n == N - 1) { const float* s = RS + ((size_t)ru * 2 + 0) * 4096 + d * 64 + e0; float* o = P.out + O_RF + ((size_t)((b * 2 + l) * 4 + h)) * 4096 + d * 64 + e0;
#pragma unroll
            for (int e = 0; e < 8; ++e) o[e] = rf[e] * Gf + s[e]; }
        if (ctx && n == 0) { const float* s = RS + ((size_t)ru * 2 + 1) * 4096 + d * 64 + e0; float* o = P.out + O_RB + ((size_t)((b * 2 + l) * 4 + h)) * 4096 + d * 64 + e0;
#pragma unroll
            for (int e = 0; e < 8; ++e) o[e] = rb[e] * Gb + s[e]; }
    }
    {   const int cc = tid & 7, pr = tid >> 3;
#pragma unroll
        for (int i = 0; i < 2; ++i) { const int p = pr + 64 * i;
            const u32x4 qr = qkv[i][0], kr = qkv[i][1], vr = qkv[i][2];
            *(LAS u32x4*)(QL + p * 144 + 16 * cc) = qr; *(LAS u32x4*)(KL + p * 144 + 16 * cc) = kr;
            *(LAS bf16*)(VT + (8 * cc + 0) * 272 + p * 2) = (bf16)(vr.x & 0xffffu); *(LAS bf16*)(VT + (8 * cc + 1) * 272 + p * 2) = (bf16)(vr.x >> 16);
            *(LAS bf16*)(VT + (8 * cc + 2) * 272 + p * 2) = (bf16)(vr.y & 0xffffu); *(LAS bf16*)(VT + (8 * cc + 3) * 272 + p * 2) = (bf16)(vr.y >> 16);
            *(LAS bf16*)(VT + (8 * cc + 4) * 272 + p * 2) = (bf16)(vr.z & 0xffffu); *(LAS bf16*)(VT + (8 * cc + 5) * 272 + p * 2) = (bf16)(vr.z >> 16);
            *(LAS bf16*)(VT + (8 * cc + 6) * 272 + p * 2) = (bf16)(vr.w & 0xffffu); *(LAS bf16*)(VT + (8 * cc + 7) * 272 + p * 2) = (bf16)(vr.w >> 16); }
    }
    __syncthreads();
    bf16x8 qfr[2];
#pragma unroll
    for (int ks = 0; ks < 2; ++ks) qfr[ks] = *(const LAS bf16x8*)(QL + (16 * wid + fr) * 144 + (32 * ks + 8 * fq) * 2);
    f32x4 a1[8];
#pragma unroll
    for (int jb = 0; jb < 8; ++jb) { a1[jb] = (f32x4){0.f, 0.f, 0.f, 0.f};
#pragma unroll
        for (int ks = 0; ks < 2; ++ks) { const bf16x8 kf = *(const LAS bf16x8*)(KL + (16 * jb + fr) * 144 + (32 * ks + 8 * fq) * 2); a1[jb] = MFMA16(kf, qfr[ks], a1[jb]); } }
    const int pl = 16 * wid + fr;
#pragma unroll
    for (int jb = 0; jb < 8; ++jb)
#pragma unroll
        for (int r = 0; r < 4; ++r) { const int dl = pl - (16 * jb + 4 * fq + r);
            const float fdl = (float)dl;
            const float D = ex2(fmaxf(fdl, 0.f) * lgf + fmaxf(-fdl, 0.f) * lgb) + fmaxf(1.f - fabsf(fdl), 0.f);
            a1[jb][r] *= D * 0.125f; }
    f32x4 a2[4], aF[4], aB[4];
#pragma unroll
    for (int eb = 0; eb < 4; ++eb) { a2[eb] = (f32x4){0.f, 0.f, 0.f, 0.f}; aF[eb] = a2[eb]; aB[eb] = a2[eb]; }
#pragma unroll
    for (int k2 = 0; k2 < 4; ++k2) {
        u32x4 pw; pw.x = pk2(a1[2 * k2][0], a1[2 * k2][1]); pw.y = pk2(a1[2 * k2][2], a1[2 * k2][3]); pw.z = pk2(a1[2 * k2 + 1][0], a1[2 * k2 + 1][1]); pw.w = pk2(a1[2 * k2 + 1][2], a1[2 * k2 + 1][3]);
        const bf16x8 pb = __builtin_bit_cast(bf16x8, pw);
#pragma unroll
        for (int eb = 0; eb < 4; ++eb) { const s16x4 lo = *(const LAS s16x4*)(VT + (16 * eb + fr) * 272 + (32 * k2 + 4 * fq) * 2), hi = *(const LAS s16x4*)(VT + (16 * eb + fr) * 272 + (32 * k2 + 16 + 4 * fq) * 2);
            const bf16x8 va = __builtin_shufflevector(lo, hi, 0, 1, 2, 3, 4, 5, 6, 7); a2[eb] = MFMA16(va, pb, a2[eb]); }
    }
#pragma unroll
    for (int ks = 0; ks < 2; ++ks)
#pragma unroll
        for (int eb = 0; eb < 4; ++eb) { const bf16x8 rfv = *(const LAS bf16x8*)(RfT + (16 * eb + fr) * 144 + (32 * ks + 8 * fq) * 2), rbv = *(const LAS bf16x8*)(RbT + (16 * eb + fr) * 144 + (32 * ks + 8 * fq) * 2);
            aF[eb] = MFMA16(rfv, qfr[ks], aF[eb]); aB[eb] = MFMA16(rbv, qfr[ks], aB[eb]); }
    const float qdf = ex2((float)(pl + 1) * lgf), qdb = ex2((float)(128 - pl) * lgb);
    float ss = 0.f;
#pragma unroll
    for (int eb = 0; eb < 4; ++eb) { a2[eb] = a2[eb] + aF[eb] * qdf + aB[eb] * qdb; ss += (a2[eb][0] * a2[eb][0] + a2[eb][1] * a2[eb][1]) + (a2[eb][2] * a2[eb][2] + a2[eb][3] * a2[eb][3]); }
    ss += __shfl_xor(ss, 16); ss += __shfl_xor(ss, 32);
    const float rstd = rsqrtf(ss * (1.f / 64.f) + EPS);
    const float* rn = P.in[I_RETN] + (l * 4 + h) * 64;
#pragma unroll
    for (int eb = 0; eb < 4; ++eb) { const int e0 = 16 * eb + 4 * fq;
        const u32x2 gr = *(const u32x2*)(Z + (m0 + pl) * INW + 1280 + 64 * h + e0); const f32x4 w = *(const f32x4*)(rn + e0);
        const float y0 = a2[eb][0] * rstd * w[0] * silu_f(bflo(gr.x)), y1 = a2[eb][1] * rstd * w[1] * silu_f(bfhi(gr.x)), y2 = a2[eb][2] * rstd * w[2] * silu_f(bflo(gr.y)), y3 = a2[eb][3] * rstd * w[3] * silu_f(bfhi(gr.y));
        u32x2 o; o.x = pk2(y0, y1); o.y = pk2(y2, y3);
        *(u32x2*)(YC + (m0 + pl) * DM + 256 + 64 * h + e0) = o; }
}
DI void cprep_unit(const Params& P, int l, int cu, ldsp lds) {
    const int tid = opaque_tid();
    const bf16* Z = (const bf16*)(P.ws + WS_Z); bf16* Q = (bf16*)(P.ws + WS_Q); const float* tab = (const float*)(P.ws + WS_TAB);
    const int m0 = cu * 64; const bool ctx = m0 < NCTX;
    const int b = ctx ? (m0 >> 8) : ((m0 - NCTX) >> 10), t0 = ctx ? (m0 & 255) : ((m0 - NCTX) & 1023);
    {   const int c = tid & 7, gs = tid >> 3;
        u32x4 raws[16];
#pragma unroll
        for (int i = 0; i < 16; ++i) { const int item = gs + 64 * i, tok = item >> 4, grp = item & 15; raws[i] = *(const u32x4*)(Z + (size_t)(m0 + tok) * INW + 1536 + grp * 64 + 8 * c); }
#pragma unroll
        for (int i = 0; i < 16; ++i) { const int item = gs + 64 * i, tok = item >> 4, grp = item & 15, m = m0 + tok, t = t0 + tok;
            const u32x4 raw = raws[i];
            float f[8]; unpack8(raw, f); float ss = 0.f;
#pragma unroll
            for (int e = 0; e < 8; ++e) ss += f[e] * f[e];
            ss += __shfl_xor(ss, 1); ss += __shfl_xor(ss, 2); ss += __shfl_xor(ss, 4);
            const float rstd = rsqrtf(ss * (1.f / 64.f) + EPS);
            const float* gp = (grp >> 3) ? P.in[I_KN] + l * 64 + 8 * c : P.in[I_QN] + l * 64 + 8 * c;
            float y[8];
#pragma unroll
            for (int e = 0; e < 8; ++e) y[e] = f[e] * rstd * gp[e];
            if (!ctx) { const int pos = (c < 4) ? (t >> 6) : (t & 63); const float* tp = tab + (pos * 16 + (c & 1) * 8) * 2; const bool first = (c & 2) == 0;
#pragma unroll
                for (int e = 0; e < 8; ++e) { const float pr = __shfl_xor(y[e], 2); const float cs = tp[2 * e], sn = tp[2 * e + 1];
                    y[e] = first ? (y[e] * cs - pr * sn) : (pr * sn + y[e] * cs); } }
            if (grp < 8) {
#pragma unroll
                for (int e = 0; e < 8; ++e) y[e] *= 0.18033688011112042f;
                *(u32x4*)(Q + (size_t)m * 512 + grp * 64 + 8 * c) = pack8(y);
            } else { const int g2 = grp - 8, h = g2 >> 1, half = g2 & 1;
                bf16* kd = ctx ? (bf16*)(P.ws + WS_KCTX) + ((size_t)(b * 4 + h) * 256 + t) * 128 + half * 64 + 8 * c : (bf16*)(P.ws + WS_KSMP) + ((size_t)(b * 4 + h) * 1280 + 256 + t) * 128 + half * 64 + 8 * c;
                *(u32x4*)kd = pack8(y);
                if (ctx) { float* ok = P.out + O_CK + ((size_t)(b * 2 + l) * 256 + t) * 512 + g2 * 64 + 8 * c; *(f32x4*)ok = (f32x4){y[0], y[1], y[2], y[3]}; *(f32x4*)(ok + 4) = (f32x4){y[4], y[5], y[6], y[7]}; } }
        }
    }
    ldsp VL = lds;
    u32x4 vraws[8];
#pragma unroll
    for (int i = 0; i < 8; ++i) { const int id = tid + 512 * i, tok = id >> 6, cc = id & 63; vraws[i] = *(const u32x4*)(Z + (size_t)(m0 + tok) * INW + 2560 + 8 * cc); }
#pragma unroll
    for (int i = 0; i < 8; ++i) { const int id = tid + 512 * i, tok = id >> 6, cc = id & 63;
        const u32x4 raw = vraws[i];
        *(LAS u32x4*)(VL + tok * 1040 + 16 * (cc ^ ((tok >> 3) & 7))) = raw;
        if (ctx) { float f[8]; unpack8(raw, f); float* ov = P.out + O_CV + ((size_t)(b * 2 + l) * 256 + t0 + tok) * 512 + 8 * cc; *(f32x4*)ov = (f32x4){f[0], f[1], f[2], f[3]}; *(f32x4*)(ov + 4) = (f32x4){f[4], f[5], f[6], f[7]}; } }
    __syncthreads();
#pragma unroll 2
    for (int i = 0; i < 8; ++i) { const int id = tid + 512 * i, kc = id & 7, col = id >> 3;
        unsigned short v[8];
#pragma unroll
        for (int e = 0; e < 8; ++e) v[e] = *(const LAS bf16*)(VL + (8 * kc + e) * 1040 + 16 * ((col >> 3) ^ kc) + (col & 7) * 2);
        u32x4 o; o.x = v[0] | ((unsigned)v[1] << 16); o.y = v[2] | ((unsigned)v[3] << 16); o.z = v[4] | ((unsigned)v[5] << 16); o.w = v[6] | ((unsigned)v[7] << 16);
        bf16* vd = ctx ? (bf16*)(P.ws + WS_VTCTX) + ((size_t)b * 512 + col) * 256 + t0 + 8 * kc : (bf16*)(P.ws + WS_VTSMP) + ((size_t)b * 512 + col) * 1280 + 256 + t0 + 8 * kc;
        *(u32x4*)vd = o; }
}
DI void attn_unit(const Params& P, int l, int au, ldsp lds, float lam, float osc) {
    const int tid = opaque_tid(), lane = tid & 63, wid = tid >> 6, r32 = lane & 31, hh = lane >> 5, rg = wid & 3, kg = wid >> 2;
    int b, h, qrow0, np, ldvt; const bf16 *Kb, *VTb;
    if (au < 256) { b = au >> 5; h = (au >> 3) & 3; const int qb = au & 7; qrow0 = NCTX + b * 1024 + qb * 128; np = 10; ldvt = 1280;
        Kb = (const bf16*)(P.ws + WS_KSMP) + ((size_t)(b * 4 + h) * 1280) * 128; VTb = (const bf16*)(P.ws + WS_VTSMP) + ((size_t)(b * 4 + h) * 128) * 1280; }
    else { const int a2 = au - 256; b = a2 >> 3; h = (a2 >> 1) & 3; qrow0 = b * 256 + 128 * (a2 & 1); np = 2; ldvt = 256;
        Kb = (const bf16*)(P.ws + WS_KCTX) + ((size_t)(b * 4 + h) * 256) * 128; VTb = (const bf16*)(P.ws + WS_VTCTX) + ((size_t)(b * 4 + h) * 128) * 256; }
    ldsp KL = lds + kg * 17408; ldsp VL = lds + 34816 + kg * 18432;
    ldsp ST = lds + 73728;
    const bf16* qp = (const bf16*)(P.ws + WS_Q) + (size_t)(qrow0 + 32 * rg + r32) * 512 + h * 128;
    bf16x8 qf[2][4];
#pragma unroll
    for (int i = 0; i < 2; ++i)
#pragma unroll
        for (int s = 0; s < 4; ++s) qf[i][s] = *(const bf16x8*)(qp + i * 64 + 16 * s + 8 * hh);
    u32x4 kreg[4], vreg[4];
    float mm[2] = {-INFINITY, -INFINITY}, ll[2] = {0.f, 0.f};
#define LOADK(tp) do { _Pragma("unroll") for (int _i = 0; _i < 4; ++_i) { const int _id = tid + 512 * _i; kreg[_i] = *(const u32x4*)(Kb + (size_t)(128 * (tp) + (_id >> 4)) * 128 + 8 * (_id & 15)); } } while (0)
#define LOADV(tp) do { _Pragma("unroll") for (int _i = 0; _i < 4; ++_i) { const int _id = tid + 512 * _i; vreg[_i] = *(const u32x4*)(VTb + (size_t)((_id >> 3) & 127) * ldvt + 128 * (tp) + 64 * (_id >> 10) + 8 * (_id & 7)); } } while (0)
#define STOREK() do { _Pragma("unroll") for (int _i = 0; _i < 4; ++_i) { const int _id = tid + 512 * _i; *(LAS u32x4*)(lds + (_id >> 10) * 17408 + ((_id >> 4) & 63) * 272 + 16 * (_id & 15)) = kreg[_i]; } } while (0)
#define STOREV() do { _Pragma("unroll") for (int _i = 0; _i < 4; ++_i) { const int _id = tid + 512 * _i; *(LAS u32x4*)(lds + 34816 + (_id >> 10) * 18432 + ((_id >> 3) & 127) * 144 + 16 * (_id & 7)) = vreg[_i]; } } while (0)
    LOADK(0);
    for (int tp = 0; tp < np; ++tp) {
        __syncthreads(); STOREK(); __syncthreads();
        if (tp + 1 < np) LOADK(tp + 1);
#pragma unroll
        for (int i = 0; i < 2; ++i) {
            f32x16 s0, s1;
#pragma unroll
            for (int r = 0; r < 16; ++r) { s0[r] = 0.f; s1[r] = 0.f; }
#pragma unroll
            for (int s = 0; s < 4; ++s) { const bf16x8 k0 = *(const LAS bf16x8*)(KL + r32 * 272 + (64 * i + 16 * s + 8 * hh) * 2), k1 = *(const LAS bf16x8*)(KL + (32 + r32) * 272 + (64 * i + 16 * s + 8 * hh) * 2);
                s0 = MFMA32(k0, qf[i][s], s0); s1 = MFMA32(k1, qf[i][s], s1); }
            float mx = s0[0];
#pragma unroll
            for (int r = 0; r < 16; ++r) mx = fmaxf(mx, fmaxf(s0[r], s1[r]));
            mx = fmaxf(mx, __shfl_xor(mx, 32));
            const float mn = fmaxf(mm[i], mx); float sum = 0.f;
#pragma unroll
            for (int r = 0; r < 16; ++r) sum += ex2(s0[r] - mn) + ex2(s1[r] - mn);
            ll[i] = ll[i] * ex2(mm[i] - mn) + sum; mm[i] = mn;
        }
    }
    ll[0] += __shfl_xor(ll[0], 32); ll[1] += __shfl_xor(ll[1], 32);
    if (hh == 0) {
#pragma unroll
        for (int i = 0; i < 2; ++i) *(LAS f32x2_t*)(ST + (((kg * 4 + rg) * 2 + i) * 32 + r32) * 8) = (f32x2_t){mm[i], ll[i]};
    }
    LOADK(0); LOADV(0);
    __syncthreads();
    float nb[2];
#pragma unroll
    for (int i = 0; i < 2; ++i) { const f32x2_t o2 = *(const LAS f32x2_t*)(ST + ((((1 - kg) * 4 + rg) * 2 + i) * 32 + r32) * 8);
        const float M = fmaxf(mm[i], o2[0]); const float L = ll[i] * ex2(mm[i] - M) + o2[1] * ex2(o2[0] - M); nb[i] = -(M + __builtin_amdgcn_logf(L)); }
    nb[1] += __builtin_amdgcn_logf(fabsf(lam));
    const float lsgn = lam < 0.f ? -1.f : 1.f;
    f32x16 o[4];
#pragma unroll
    for (int d = 0; d < 4; ++d)
#pragma unroll
        for (int r = 0; r < 16; ++r) o[d][r] = 0.f;
    for (int tp = 0; tp < np; ++tp) {
        __syncthreads(); STOREK(); STOREV(); __syncthreads();
        if (tp + 1 < np) { LOADK(tp + 1); LOADV(tp + 1); }
#pragma unroll
        for (int kb = 0; kb < 2; ++kb) {
            f32x16 pa, s1;
#pragma unroll
            for (int r = 0; r < 16; ++r) { pa[r] = nb[0]; s1[r] = nb[1]; }
#pragma unroll
            for (int s = 0; s < 4; ++s) { const bf16x8 kf = *(const LAS bf16x8*)(KL + (32 * kb + r32) * 272 + (16 * s + 8 * hh) * 2); pa = MFMA32(kf, qf[0][s], pa); }
#pragma unroll
            for (int s = 0; s < 4; ++s) { const bf16x8 kf = *(const LAS bf16x8*)(KL + (32 * kb + r32) * 272 + (64 + 16 * s + 8 * hh) * 2); s1 = MFMA32(kf, qf[1][s], s1); }
#pragma unroll
            for (int r = 0; r < 16; ++r) pa[r] = ex2(pa[r]) - lsgn * ex2(s1[r]);
#pragma unroll
            for (int sp = 0; sp < 2; ++sp) { const int ks = 2 * kb + sp;
                u32x4 pw; pw.x = pk2(pa[8 * sp + 0], pa[8 * sp + 1]); pw.y = pk2(pa[8 * sp + 2], pa[8 * sp + 3]); pw.z = pk2(pa[8 * sp + 4], pa[8 * sp + 5]); pw.w = pk2(pa[8 * sp + 6], pa[8 * sp + 7]);
                const bf16x8 pb = __builtin_bit_cast(bf16x8, pw);
#pragma unroll
                for (int d = 0; d < 4; ++d) { const s16x4 lo = *(const LAS s16x4*)(VL + (32 * d + r32) * 144 + (16 * ks + 4 * hh) * 2), hi = *(const LAS s16x4*)(VL + (32 * d + r32) * 144 + (16 * ks + 8 + 4 * hh) * 2);
                    const bf16x8 va = __builtin_shufflevector(lo, hi, 0, 1, 2, 3, 4, 5, 6, 7); o[d] = MFMA32(va, pb, o[d]); }
            }
        }
    }
#undef LOADK
#undef LOADV
#undef STOREK
#undef STOREV
    __syncthreads();
    ldsp OX = lds + (32 * rg + r32) * 528;
    if (kg == 1) {
#pragma unroll
        for (int d = 0; d < 4; ++d)
#pragma unroll
            for (int g4 = 0; g4 < 4; ++g4) *(LAS f32x4*)(OX + (32 * d + 8 * g4 + 4 * hh) * 4) = (f32x4){o[d][4 * g4 + 0], o[d][4 * g4 + 1], o[d][4 * g4 + 2], o[d][4 * g4 + 3]};
    }
    __syncthreads();
    if (kg == 0) {
        float ss = 0.f;
#pragma unroll
        for (int d = 0; d < 4; ++d)
#pragma unroll
            for (int g4 = 0; g4 < 4; ++g4) { const f32x4 t = *(const LAS f32x4*)(OX + (32 * d + 8 * g4 + 4 * hh) * 4);
#pragma unroll
                for (int e = 0; e < 4; ++e) { o[d][4 * g4 + e] += t[e]; ss += o[d][4 * g4 + e] * o[d][4 * g4 + e]; } }
        ss += __shfl_xor(ss, 32);
        const float rstd = rsqrtf(ss * (1.f / 128.f) + EPS) * osc;
        const float* dn = P.in[I_DN] + l * 128;
        bf16* dst = (bf16*)(P.ws + WS_H) + (size_t)(qrow0 + 32 * rg + r32) * DM + 512 + h * 128;
#pragma unroll
        for (int d = 0; d < 4; ++d)
#pragma unroll
            for (int g4 = 0; g4 < 4; ++g4) { const int d0 = 32 * d + 8 * g4 + 4 * hh; const f32x4 w = *(const f32x4*)(dn + d0);
                u32x2 ov; ov.x = pk2(o[d][4 * g4 + 0] * rstd * w[0], o[d][4 * g4 + 1] * rstd * w[1]); ov.y = pk2(o[d][4 * g4 + 2] * rstd * w[2], o[d][4 * g4 + 3] * rstd * w[3]);
                *(u32x2*)(dst + d0) = ov; }
    }
}
DI void unpack8v(const u32x4 r, f32x2_t (&f)[4]) { f[0] = (f32x2_t){bflo(r.x), bfhi(r.x)}; f[1] = (f32x2_t){bflo(r.y), bfhi(r.y)}; f[2] = (f32x2_t){bflo(r.z), bfhi(r.z)}; f[3] = (f32x2_t){bflo(r.w), bfhi(r.w)}; }
DI void phase_convgate(const Params& P, int l, int hf) {
    const bf16* __restrict__ UP = (const bf16*)(P.ws + WS_UP); bf16* __restrict__ Gb = (bf16*)(P.ws + WS_G) + (size_t)hf * 8192 * DFF;
    const int seqlen = hf ? 1024 : 256;
    const float* __restrict__ cw = P.in[I_FCONV] + (size_t)l * 3 * UPW; const float* __restrict__ cb = P.in[I_FCB] + (size_t)l * UPW;
    const int nitems = 1024 * 352;
    for (int it = blockIdx.x * 512 + opaque_tid(); it < nitems; it += gridDim.x * 512) {
        const int strip = it / 352, ch = it % 352, n0 = 8 * ch, r0 = strip * 8, t0 = r0 % seqlen;
        u32x4 ra[10], rb[10];
        const bool has_prev = t0 != 0, has_next = (t0 + 8) != seqlen;
#pragma unroll
        for (int i = 0; i < 10; ++i) { const int r = r0 - 1 + i; const bool ok = (i == 0) ? has_prev : ((i == 9) ? has_next : true);
            if (ok) { ra[i] = *(const u32x4*)(UP + (size_t)r * UPW + n0); rb[i] = *(const u32x4*)(UP + (size_t)r * UPW + DFF + n0); }
            else { ra[i] = (u32x4){0u, 0u, 0u, 0u}; rb[i] = ra[i]; } }
        f32x2_t wa[3][4], wb[3][4], ba[4], bb[4];
#pragma unroll
        for (int j = 0; j < 3; ++j)
#pragma unroll
            for (int q = 0; q < 4; ++q) { wa[j][q] = *(const f32x2_t*)(cw + j * UPW + n0 + 2 * q); wb[j][q] = *(const f32x2_t*)(cw + j * UPW + DFF + n0 + 2 * q); }
#pragma unroll
        for (int q = 0; q < 4; ++q) { ba[q] = *(const f32x2_t*)(cb + n0 + 2 * q); bb[q] = *(const f32x2_t*)(cb + DFF + n0 + 2 * q); }
        f32x2_t pa[4], pb[4], ca[4], cbv[4], na[4], nb[4];
        unpack8v(ra[0], pa); unpack8v(rb[0], pb); unpack8v(ra[1], ca); unpack8v(rb[1], cbv);
#pragma unroll
        for (int rr = 0; rr < 8; ++rr) { const int r = r0 + rr;
            unpack8v(ra[rr + 2], na); unpack8v(rb[rr + 2], nb);
            u32x4 o; unsigned ow[4];
#pragma unroll
            for (int q = 0; q < 4; ++q) { const f32x2_t ya = wa[0][q] * pa[q] + wa[1][q] * ca[q] + wa[2][q] * na[q] + ba[q], yb = wb[0][q] * pb[q] + wb[1][q] * cbv[q] + wb[2][q] * nb[q] + bb[q];
                const f32x2_t tt = ya * -1.4426950409f; f32x2_t e; e.x = ex2(tt.x); e.y = ex2(tt.y); e = e + 1.f;
                f32x2_t rc; rc.x = __builtin_amdgcn_rcpf(e.x); rc.y = __builtin_amdgcn_rcpf(e.y);
                const f32x2_t g = (ya * rc) * yb; ow[q] = pk2(g.x, g.y);
                pa[q] = ca[q]; pb[q] = cbv[q]; ca[q] = na[q]; cbv[q] = nb[q]; }
            o.x = ow[0]; o.y = ow[1]; o.z = ow[2]; o.w = ow[3];
            *(u32x4*)(Gb + (size_t)r * DFF + n0) = o; }
    }
}

#define XB_TMO      128
#define XB_XCNT(j)  (256  + 64 * (j))
#define XB_XSUB(j)  (1280 + 64 * (j))
#define XB_XGEN(j)  (2304 + 64 * (j))
#define XB_TOP      3328
#define XB_TOPGEN   3392
#define XCD_BAR_WORDS 3456
#define XB_SPIN_CAP (1u << 18)

__device__ __forceinline__ unsigned xb_ld(unsigned* p)              { return __hip_atomic_load(p, __ATOMIC_RELAXED, __HIP_MEMORY_SCOPE_AGENT); }
__device__ __forceinline__ unsigned xb_add(unsigned* p, unsigned v) { return __hip_atomic_fetch_add(p, v, __ATOMIC_RELAXED, __HIP_MEMORY_SCOPE_AGENT); }
__device__ __forceinline__ unsigned xb_xcc_id() { return (unsigned)__builtin_amdgcn_s_getreg((3 << 11) | 20) & 0xFu; }
#define XB_SPIN(cond, bar) do { unsigned _sp = 0; while (cond) { __builtin_amdgcn_s_sleep(1); \
    if ((++_sp & 255u) == 0u) { if (xb_ld(&(bar)[XB_TMO])) break; if (_sp > XB_SPIN_CAP) { atomicAdd(&(bar)[XB_TMO], 1u); break; } } } } while (0)

struct XcdBarrier {
    unsigned* bar; unsigned x;
    volatile LAS unsigned* st;
};

__device__ __forceinline__ XcdBarrier xcd_barrier_post(unsigned* bar, volatile LAS unsigned* st) {
    XcdBarrier b; b.bar = bar; b.x = xb_xcc_id(); b.st = st;
    if (threadIdx.x == 0) (void)xb_add(&bar[XB_XCNT(b.x)], 1u);
    return b;
}
__device__ __forceinline__ void xcd_barrier_complete(unsigned* bar, unsigned x, unsigned& nloc, unsigned& nx) {
    const unsigned G = gridDim.x * gridDim.y * gridDim.z;
    unsigned sum, cnt, mine, sp = 0u;
    for (;;) {
        sum = 0u; cnt = 0u; mine = 0u;
#pragma unroll
        for (unsigned j = 0; j < 16; ++j) { const unsigned c = xb_ld(&bar[XB_XCNT(j)]); sum += c; cnt += (c > 0u) ? 1u : 0u; mine = (j == x) ? c : mine; }
        if (sum == G) break;
        __builtin_amdgcn_s_sleep(1);
        if ((++sp & 255u) == 0u) { if (xb_ld(&bar[XB_TMO])) break; if (sp > XB_SPIN_CAP) { atomicAdd(&bar[XB_TMO], 1u); break; } }
    }
    nloc = mine > 0u ? mine : 1u; nx = cnt > 0u ? cnt : 1u;
}

__device__ __forceinline__ void xcd_barrier(const XcdBarrier& b) {
    asm volatile("s_waitcnt vmcnt(0)" ::: "memory");
    __syncthreads();
    if (threadIdx.x == 0) {
        unsigned* bar = b.bar;
        __builtin_amdgcn_s_waitcnt(0);
        unsigned nloc = b.st[0], nx = b.st[1];
        if (nloc == 0u) { xcd_barrier_complete(bar, b.x, nloc, nx); b.st[0] = nloc; b.st[1] = nx; }
        const unsigned old = xb_add(&bar[XB_XSUB(b.x)], 1u);
        const unsigned gen = old / nloc;
        if (old + 1u == (gen + 1u) * nloc) {
            __builtin_amdgcn_fence(__ATOMIC_RELEASE, "agent");
            asm volatile("s_waitcnt vmcnt(0)" ::: "memory");
            const unsigned og = xb_add(&bar[XB_TOP], 1u);
            const unsigned tg = og / nx;
            if (og + 1u == (tg + 1u) * nx) xb_add(&bar[XB_TOPGEN], 1u);
            else XB_SPIN(xb_ld(&bar[XB_TOPGEN]) == tg, bar);
            __builtin_amdgcn_fence(__ATOMIC_ACQUIRE, "agent");
            xb_add(&bar[XB_XGEN(b.x)], 1u);
            asm volatile("s_waitcnt vmcnt(0)" ::: "memory");
        } else {
            XB_SPIN(xb_ld(&bar[XB_XGEN(b.x)]) == gen, bar);
            __builtin_amdgcn_fence(__ATOMIC_ACQUIRE, "agent");
            asm volatile("s_waitcnt vmcnt(0)" ::: "memory");
        }
    }
    __syncthreads();
}

constexpr size_t WS_BAR = 16 * 1024;
#ifndef EN_G1
#define EN_G1 1
#endif
#ifndef EN_G2
#define EN_G2 1
#endif
#ifndef EN_MA
#define EN_MA 1
#endif
#ifndef EN_MB
#define EN_MB 1
#endif
#ifndef EN_AT
#define EN_AT 1
#endif
#ifndef EN_RO
#define EN_RO 1
#endif
#ifndef EN_CG
#define EN_CG 1
#endif
#ifndef DUP_MASK
#define DUP_MASK 0
#endif
#ifndef DUP_SKIP
#define DUP_SKIP 0
#endif
#define REPS(k) (((DUP_MASK >> (k)) & 1) ? 2 : 1)
#define REPLOOP(k) _Pragma("unroll") for (int rep = 0; rep < REPS(k); ++rep)
#define REPSYNC(k) do { if (rep + 1 < REPS(k)) xcd_barrier(xbar); } while (0)
#define IN(k) (lo <= (k) && (k) < hi)
#ifndef SYNC_REPS
#define SYNC_REPS 1
#endif
#define SEAM(k) do { if (IN(k) && IN((k) + 1)) { for (int _s = 0; _s < SYNC_REPS; ++_s) xcd_barrier(xbar); } } while (0)
template <int L> DI void layer_phases(const Params& P, ldsp lds, const int lo, const int hi, const XcdBarrier& xbar) {
    constexpr int B = 1 + 11 * L;
    const int G = gridDim.x;
    const float* mods_l = (const float*)(P.ws + WS_MODS) + (size_t)L * 9 * 6144;
    const bf16* win_t = (const bf16*)(P.ws + (L ? WS_WIN1 : WS_WIN)); const bf16* wout_t = (const bf16*)(P.ws + (L ? WS_WOUT1 : WS_WOUT)); const bf16* wup_t = (const bf16*)(P.ws + (L ? WS_WUP1 : WS_WUP));
    float* SS2 = (float*)(P.ws + WS_SS) + (L == 0 ? 0 : 2) * 16384; float* SS1 = (float*)(P.ws + WS_SS) + 16384; const float* shw = (const float*)(P.ws + WS_SHW);
    if (L == 0) {
        if (IN(B + 0)) REPLOOP(12) { phase_norm(P, P.in[I_XP], P.in[I_XS], P.in[I_N1], mods_l, 0, 1024); __syncthreads(); phase_shw(P, lds); REPSYNC(12); }
        SEAM(B + 0);
    }
    if (EN_G1 && IN(B + 1)) REPLOOP(1) {
        pg8::Gemm g{(const bf16*)(P.ws + WS_H), win_t, MTOK, INW, DM};
        pg8::StaticOrder S; S.init(MTOK, INW, G, (int)blockIdx.x);
        if (L == 0) { pg8::EpiBf16<0> E{(bf16*)(P.ws + WS_Z), INW, nullptr, 0, 0, 1.f}; pg8::gemm_phase<pg8::EpiBf16<0>, pg8::StaticOrder, true, true>(lds, g, S, E); }
        else { EpiBf16Fold E{(bf16*)(P.ws + WS_Z), INW, SS1, shw + SHW_SET, INW, 0}; pg8::gemm_phase<EpiBf16Fold, pg8::StaticOrder, true, true>(lds, g, S, E); }
        REPSYNC(1);
    }
    SEAM(B + 1);
    if (EN_MA && IN(B + 2)) REPLOOP(2) {
        if (L > 0) phase_prep(P, L, lds, 2 | 4);
        __syncthreads();
        for (int vb = blockIdx.x; vb < 256; vb += G) {
            sgu_unit(P, L, vb >> 1, lds, vb & 1); __syncthreads();
            cprep_unit(P, L, vb, lds); __syncthreads();
            rets_unit(P, L, 2 * vb, lds); __syncthreads(); rets_unit(P, L, 2 * vb + 1, lds); __syncthreads();
        }
        REPSYNC(2);
    }
    SEAM(B + 2);
    if (EN_MB && IN(B + 3)) REPLOOP(3) {
        unsigned* ctr = (unsigned*)(P.ws + WS_CTR) + (B + 3) + 32 * rep;
        const float* dl = P.in[I_DLAM] + L * 256; const int lane = opaque_tid() & 63;
        const float s1 = wave_sum(dl[lane] * dl[64 + lane]), s2 = wave_sum(dl[128 + lane] * dl[192 + lane]);
        const float lam_init = L == 0 ? 0.2f : 0.35550906759f;
        const float lam = expf(s1) - expf(s2) + lam_init;
        if (EN_AT && !(rep == 1 && (DUP_SKIP & 1))) {
#pragma unroll 1
            for (int pass = 0; pass < 2; ++pass)
#pragma unroll 1
                for (int vb = blockIdx.x; vb < 256; vb += G) { const int x = vb & 7, sl = vb >> 3;
                    const int u = pass == 0 ? (4 * x + (sl >> 3)) * 8 + (sl & 7) : 256 + (16 * x + (sl >> 1)) * 2 + (sl & 1);
                    __syncthreads(); attn_unit(P, L, u, lds, lam, 1.f - lam_init); }
        }
        if (EN_RO && !(rep == 1 && (DUP_SKIP & 2))) for (int u = blockIdx.x; u < 512; u += G) { __syncthreads(); reto_unit(P, L, u, lds); }
        REPSYNC(3);
    }
    SEAM(B + 3);
    if (EN_G2 && IN(B + 4)) {
        pg8::Gemm g{(const bf16*)(P.ws + WS_H), wout_t, MTOK, DM, DM};
        EpiResidFold<L == 0 ? 1 : 0> E{L == 0 ? P.in[I_XP] : P.out, L == 0 ? P.in[I_XS] : P.out + (size_t)NCTX * DM, P.out, mods_l + 2048, P.in[I_N2] + L * DM, mods_l + 4096, (bf16*)(P.ws + WS_H2), SS2};
        pg8::StaticOrder S; S.init(MTOK, DM, G, (int)blockIdx.x);
        pg8::gemm_phase<EpiResidFold<L == 0 ? 1 : 0>, pg8::StaticOrder, true, true>(lds, g, S, E);
    }
    SEAM(B + 4);
#pragma unroll
    for (int hf = 0; hf < 2; ++hf) {
        if (EN_G1 && IN(B + 6 + 2 * hf)) REPLOOP(6) {
            pg8::Gemm g{(const bf16*)(P.ws + WS_H2) + (size_t)hf * 8192 * DM, wup_t, 8192, UPW, DM};
            EpiBf16Fold E{(bf16*)(P.ws + WS_UP), UPW, SS2, shw + (L == 0 ? 0 : 2 * SHW_SET), UPW, 32 * hf};
            pg8::StaticOrder S; S.init(8192, UPW, G, (int)blockIdx.x);
            pg8::gemm_phase<EpiBf16Fold, pg8::StaticOrder, true, true>(lds, g, S, E);
            if (L == 0 && rep == 0 && G == 256 && blockIdx.x >= 192) { __syncthreads(); phase_prep(P, 1, lds, 1, 192, 64, hf); }
            REPSYNC(6);
        }
        SEAM(B + 6 + 2 * hf);
        if (EN_CG && IN(B + 7 + 2 * hf)) REPLOOP(7) { phase_convgate(P, L, hf); REPSYNC(7); }
        SEAM(B + 7 + 2 * hf);
    }
    if (EN_G2 && IN(B + 10)) {
        pg8::Gemm g{(const bf16*)(P.ws + WS_G), (const bf16*)(P.ws + WS_WDN), MTOK, DM, DFF};
        pg8::StaticOrder S; S.init(MTOK, DM, G, (int)blockIdx.x);
        if (L == 0) {
            const float* mods_n = (const float*)(P.ws + WS_MODS) + (size_t)9 * 6144;
            EpiResidFold<2> E{P.out, P.out + (size_t)NCTX * DM, P.out, mods_l + 5120, P.in[I_N1] + DM, mods_n + 1024, (bf16*)(P.ws + WS_H), SS1};
            pg8::gemm_phase<EpiResidFold<2>, pg8::StaticOrder, true, true>(lds, g, S, E);
        } else { EpiResid E{P.out, P.out + (size_t)NCTX * DM, P.out, mods_l + 5120}; pg8::gemm_phase<EpiResid, pg8::StaticOrder, true, true>(lds, g, S, E); }
    }
    if (L == 0) SEAM(B + 10);
}
__global__ void __launch_bounds__(512, 2) mk_fwd(Params P) {
    extern __shared__ __attribute__((aligned(16))) unsigned char lds_raw[];
    ldsp lds = (ldsp)lds_raw;
    cg::grid_group grid = cg::this_grid();
    const int lo = P.ph_lo, hi = P.ph_hi;
    if (threadIdx.x < 8) ((LAS unsigned*)(lds + LDS_MAIN))[threadIdx.x] = 0u;
    __syncthreads();
    unsigned* barw = (unsigned*)(P.ws + WS_BAR);
    if (P.coop == 2) grid.sync();
    XcdBarrier xbar; xbar.bar = barw; xbar.x = 0; xbar.st = nullptr;
    if (hi - lo > 1) xbar = xcd_barrier_post(barw, (volatile LAS unsigned*)(lds + LDS_MAIN + 16));
    if (IN(0)) REPLOOP(11) { phase_tables(P); phase_mods(P, lds); __syncthreads(); phase_prep(P, 0, lds, 1 | 2 | 4); if (gridDim.x != 256) phase_prep(P, 1, lds, 1); REPSYNC(11); }
    SEAM(0);
    layer_phases<0>(P, lds, lo, hi, xbar);
    layer_phases<1>(P, lds, lo, hi, xbar);
}
#undef IN
#undef SEAM

extern "C" void kernel_launch(void* const* d_in, const int* in_sizes, int n_in, void* d_out, int out_size, void* d_ws, size_t ws_size, hipStream_t stream) {
    static int grid = 0;
    if (grid == 0) {
        if (n_in != N_IN || (size_t)out_size != O_END || ws_size < WS_END) { fprintf(stderr, "kernel_launch: unexpected sizes n_in %d out %d ws %zu\n", n_in, out_size, ws_size); grid = -1; return; }
        int dev = 0, cus = 0, per_cu = 0;
        if (hipGetDevice(&dev) != hipSuccess || hipDeviceGetAttribute(&cus, hipDeviceAttributeMultiprocessorCount, dev) != hipSuccess) { grid = -1; return; }
        if (hipFuncSetAttribute((const void*)mk_fwd, hipFuncAttributeMaxDynamicSharedMemorySize, LDS_BYTES) != hipSuccess) { fprintf(stderr, "kernel_launch: hipFuncSetAttribute failed\n"); grid = -1; return; }
        if (hipOccupancyMaxActiveBlocksPerMultiprocessor(&per_cu, (const void*)mk_fwd, 512, LDS_BYTES) != hipSuccess || per_cu < 1) { per_cu = 1; (void)hipGetLastError(); }
        grid = cus * 1;
    }
    if (grid < 0) return;
    if (hipMemsetAsync(d_ws, 0, WS_ZERO_BYTES, stream) != hipSuccess) { fprintf(stderr, "kernel_launch: memset failed\n"); return; }
    Params p{};
    for (int i = 0; i < N_IN; ++i) p.in[i] = (const float*)d_in[i];
    p.out = (float*)d_out; p.ws = (unsigned char*)d_ws; p.coop = KL_COOP; p.pad = 0;
#if KL_COOP
    p.ph_lo = 0; p.ph_hi = NPH;
    void* args[] = {&p};
    hipError_t e = hipLaunchCooperativeKernel((const void*)mk_fwd, dim3(grid), dim3(512), args, LDS_BYTES, stream);
    if (e != hipSuccess) fprintf(stderr, "cooperative launch failed: %s (grid %d)\n", hipGetErrorString(e), grid);
#else
    for (int ph = 0; ph < NPH; ++ph) { p.ph_lo = ph; p.ph_hi = ph + 1; hipLaunchKernelGGL(mk_fwd, dim3(grid), dim3(512), LDS_BYTES, stream, p); }
#endif
}
```

```cpp
#include <hip/hip_runtime.h>
#include <hip/hip_cooperative_groups.h>
#include <cstdio>
#include <cstdint>
namespace cg = cooperative_groups;
#ifndef KL_COOP
#define KL_COOP 1
#endif
namespace pg8 {
#define PG8_LAS __attribute__((address_space(3)))
typedef unsigned short bf16_t;
typedef short bf16x8 __attribute__((ext_vector_type(8)));
typedef float f32x4 __attribute__((ext_vector_type(4)));
typedef unsigned u32x4 __attribute__((ext_vector_type(4)));
constexpr int BM = 256, BK = 64, HALF = 128, HTB = HALF * BK * 2  , STAGE_BYTES = 8 * HTB, NXCD = 8, WGM = 8;

__host__ __device__ __forceinline__ int lds_byte(int r, int c) { const int st = (r >> 4) * 2 + (c >> 5), rr = r & 15, cc = c & 31, ob = rr * 64 + cc * 2; return st * 1024 + (ob ^ (((ob >> 9) & 1) << 5)); }
__host__ __device__ __forceinline__ void stage_rc(int b, int& R, int& C) { const int st = b / 1024, sb = b % 1024, swz = sb ^ (((sb >> 9) & 1) << 5); R = (st >> 1) * 16 + swz / 64; C = (st & 1) * 32 + (swz % 64) / 2; }
__host__ __device__ __forceinline__ int perm32(int rho) { const int n = rho >> 4, i = rho & 15; return 8 * (i >> 2) + 4 * n + (i & 3); }

struct Unit { int pm, pn; };
struct Gemm { const bf16_t* A; const bf16_t* Bt; int M, N, K; };

struct StaticOrder {
    int nM, nN, nwg, G, c;
    __host__ __device__ void init(int M, int N, int G_, int c_) { nM = M / BM; nN = N / BM; nwg = nM * nN; G = G_; c = c_; }
    __host__ __device__ bool next(int i, Unit& u) const {
        const long L = (long)i * G + c; if (L >= nwg) return false;
        int wgid = (int)L; { const int q = nwg / NXCD, r = nwg % NXCD, xcd = wgid % NXCD, off = wgid / NXCD; wgid = (xcd < r ? xcd * (q + 1) : r * (q + 1) + (xcd - r) * q) + off; }
        const int nig = WGM * nN, gid = wgid / nig, fm = gid * WGM, gsz = (nM - fm) < WGM ? (nM - fm) : WGM;
        u.pm = fm + ((wgid % nig) % gsz); u.pn = (wgid % nig) / gsz; return true;
    }
    __device__ __forceinline__ void a_ready(const Unit&) const {}
    __device__ __forceinline__ void done(const Unit&) const {}
};

__device__ __forceinline__ unsigned cvt_pk_bf16(float lo, float hi) { unsigned r; asm volatile("v_cvt_pk_bf16_f32 %0, %1, %2" : "=v"(r) : "v"(lo), "v"(hi)); return r; }
typedef float f32x2 __attribute__((ext_vector_type(2)));
__device__ __forceinline__ f32x2 gelu_pk(f32x2 v) {
    const f32x2 av = __builtin_elementwise_abs(v), d = av * 0.2316418882f + 1.0f;
    f32x2 t; t.x = __builtin_amdgcn_rcpf(d.x); t.y = __builtin_amdgcn_rcpf(d.y);
    f32x2 q = t * 0.5307027145f + (-0.7265760135f); q = q * t + 0.7107068705f; q = q * t + (-0.142248368f); q = q * t + 0.127414796f; q = q * t;
    const f32x2 s = (v * v) * (-0.72134752044f);
    f32x2 e; e.x = __builtin_amdgcn_exp2f(s.x); e.y = __builtin_amdgcn_exp2f(s.y);
    const f32x2 m = v * (q * e), r = v - m;
    f32x2 o; o.x = v.x < 0.f ? m.x : r.x; o.y = v.y < 0.f ? m.y : r.y; return o;
}

template <int ACT  > struct EpiBf16 {
    static constexpr bool PERM = true, AFTER_DRAIN = false; static_assert(ACT == 0 || ACT == 1, "EpiBf16: ACT is 0 (none) or 1 (gelu_pk)");
    bf16_t* O; int ldc; const float* bias; int split_cols; size_t split_stride; float scale0;
    __device__ __forceinline__ void operator()(const f32x4 (&acc)[2][2][4][2], const Unit& u, int wr, int wc, int fr, int fq) const {
        const int row0 = u.pm * BM + wr * 64 + fr; int colt = u.pn * BM; bf16_t* base = O;
        float sc = 1.f; if (split_cols) { const int t = colt / split_cols; base += (size_t)t * split_stride; colt -= t * split_cols; if (t == 0) sc = scale0; }
        const int col0 = colt + wc * 32 + 8 * fq, bcol0 = u.pn * BM + wc * 32 + 8 * fq;
        f32x4 bv[2][2];
#pragma unroll
        for (int bj = 0; bj < 2; ++bj)
#pragma unroll
            for (int n = 0; n < 2; ++n) bv[bj][n] = bias ? *(const f32x4*)(bias + bcol0 + bj * HALF + 4 * n) : (f32x4){0.f, 0.f, 0.f, 0.f};
#pragma unroll
        for (int ai = 0; ai < 2; ++ai)
#pragma unroll
            for (int m = 0; m < 4; ++m) { bf16_t* rowp = base + (size_t)(row0 + ai * HALF + m * 16) * ldc + col0;
#pragma unroll
                for (int bj = 0; bj < 2; ++bj) { f32x4 v0 = acc[ai][bj][m][0] + bv[bj][0], v1 = acc[ai][bj][m][1] + bv[bj][1];
                    if (ACT == 1) { f32x2 a = gelu_pk((f32x2){v0[0], v0[1]}), b = gelu_pk((f32x2){v0[2], v0[3]}), c = gelu_pk((f32x2){v1[0], v1[1]}), d = gelu_pk((f32x2){v1[2], v1[3]});
                        v0 = (f32x4){a.x, a.y, b.x, b.y}; v1 = (f32x4){c.x, c.y, d.x, d.y}; }
                    v0 = v0 * sc; v1 = v1 * sc; u32x4 w; w.x = cvt_pk_bf16(v0[0], v0[1]); w.y = cvt_pk_bf16(v0[2], v0[3]); w.z = cvt_pk_bf16(v1[0], v1[1]); w.w = cvt_pk_bf16(v1[2], v1[3]);
                    *(u32x4*)(rowp + bj * HALF) = w; } }
    }
};
template <class Epi, class Sched, bool ALIGN_EPI = false, bool SP2 = false>
__device__ __forceinline__ void gemm_phase(PG8_LAS unsigned char* lds, const Gemm g, const Sched& S, const Epi& E) {
    int tid_ = threadIdx.x; asm volatile("" : "+v"(tid_));
    const int tid = tid_, wid = __builtin_amdgcn_readfirstlane(tid >> 6), lane = tid & 63, wr = wid >> 2, wc = wid & 3, fr = lane & 15, fq = lane >> 4;
    const int K = g.K, nt = K / BK;
    unsigned voffA[2], voffB[2];
#pragma unroll
    for (int i = 0; i < 2; ++i) { int R, C; stage_rc(tid * 16 + i * 8192, R, C); const int Rb = Epi::PERM ? ((R & ~31) + perm32(R & 31)) : R;
        voffA[i] = (unsigned)(R * K + C) * 2u; voffB[i] = (unsigned)(Rb * K + C) * 2u; }
    const size_t kstep = (size_t)(BK * 2);
    const size_t hstep = (size_t)HALF * K * 2;
    const size_t tstep = 2 * hstep;
    const unsigned ldsw = (unsigned)wid * 1024u;
    const int aoff = lds_byte(wr * 64 + fr, fq * 8), boff = lds_byte(wc * 32 + fr, fq * 8);
#define PG8_SA(b, h) (((b) * 2 + (h)) * HTB)
#define PG8_SB(b, h) ((4 + (b) * 2 + (h)) * HTB)
#define PG8_STAGE(bufoff, gbase, voff) do { _Pragma("unroll") for (int _i = 0; _i < 2; ++_i) \
        __builtin_amdgcn_global_load_lds((const unsigned*)((const char*)(gbase) + (voff)[_i]), (PG8_LAS unsigned*)(lds + (bufoff) + ldsw + _i * 8192), 16, 0, 0); } while (0)
#define PG8_LDA(dst, b, h) do { _Pragma("unroll") for (int m = 0; m < 4; ++m) _Pragma("unroll") for (int k = 0; k < 2; ++k) dst[m][k] = *(const PG8_LAS bf16x8*)(lds + PG8_SA(b, h) + aoff + m * 2048 + k * 1024); } while (0)
#define PG8_LDB(dst, b, h) do { _Pragma("unroll") for (int n = 0; n < 2; ++n) _Pragma("unroll") for (int k = 0; k < 2; ++k) dst[n][k] = *(const PG8_LAS bf16x8*)(lds + PG8_SB(b, h) + boff + n * 2048 + k * 1024); } while (0)
#define PG8_MMA(ai, bj, At, Bt) do { __builtin_amdgcn_s_setprio(1); _Pragma("unroll") for (int m = 0; m < 4; ++m) _Pragma("unroll") for (int n = 0; n < 2; ++n) _Pragma("unroll") for (int k = 0; k < 2; ++k) \
        acc[ai][bj][m][n] = __builtin_amdgcn_mfma_f32_16x16x32_bf16(Bt[n][k], At[m][k], acc[ai][bj][m][n], 0, 0, 0); __builtin_amdgcn_s_setprio(0); } while (0)
#define PG8_WAIT_V(n) asm volatile("s_waitcnt vmcnt(" #n ")" ::: "memory")
#define PG8_WAIT_L(n) asm volatile("s_waitcnt lgkmcnt(" #n ")" ::: "memory")
#define PG8_BAR __builtin_amdgcn_s_barrier()
#define PG8_SCHED __builtin_amdgcn_sched_barrier(0)
    Unit cur, nxt; int ui = 0;
    if (!S.next(0, cur)) return;
    f32x4 acc[2][2][4][2];
#pragma unroll
    for (int a = 0; a < 2; ++a)
#pragma unroll
        for (int b = 0; b < 2; ++b)
#pragma unroll
            for (int m = 0; m < 4; ++m)
#pragma unroll
                for (int n = 0; n < 2; ++n) acc[a][b][m][n] = (f32x4){0.f, 0.f, 0.f, 0.f};
    bf16x8 At[4][2], B0[2][2], B1[2][2];
    const char* cA = (const char*)g.A + (size_t)cur.pm * tstep; const char* cB = (const char*)g.Bt + (size_t)cur.pn * tstep;
    S.a_ready(cur);
    if constexpr (SP2) {
        PG8_STAGE(PG8_SB(0, 0), cB, voffB); PG8_STAGE(PG8_SB(0, 1), cB + hstep, voffB); PG8_STAGE(PG8_SA(0, 0), cA, voffA); PG8_STAGE(PG8_SA(0, 1), cA + hstep, voffA);
        if (wr == 1) PG8_BAR;
        PG8_WAIT_V(2); PG8_BAR;
        PG8_STAGE(PG8_SB(1, 0), cB + kstep, voffB); PG8_STAGE(PG8_SA(1, 0), cA + kstep, voffA); PG8_STAGE(PG8_SB(1, 1), cB + hstep + kstep, voffB);
        PG8_WAIT_V(6); PG8_BAR;
    } else {
        PG8_STAGE(PG8_SB(0, 0), cB, voffB); PG8_STAGE(PG8_SA(0, 0), cA, voffA); PG8_STAGE(PG8_SB(0, 1), cB + hstep, voffB); PG8_STAGE(PG8_SA(0, 1), cA + hstep, voffA);
        if (wr == 1) PG8_BAR;
        PG8_WAIT_V(4); PG8_BAR;
        PG8_STAGE(PG8_SB(1, 0), cB + kstep, voffB); PG8_STAGE(PG8_SA(1, 0), cA + kstep, voffA); PG8_STAGE(PG8_SB(1, 1), cB + hstep + kstep, voffB);
        PG8_WAIT_V(6); PG8_BAR;
    }
    for (;;) {
        const bool has_next = S.next(ui + 1, nxt);
        const char* nA = has_next ? (const char*)g.A + (size_t)nxt.pm * tstep : cA; const char* nB = has_next ? (const char*)g.Bt + (size_t)nxt.pn * tstep : cB;
        for (int t = 0; t < nt; t += 2) {
            const bool last = (t == nt - 2);
            const char* a1 = cA + (size_t)(t + 1) * kstep;
            const char* a2 = last ? nA : cA + (size_t)(t + 2) * kstep; const char* b2 = last ? nB : cB + (size_t)(t + 2) * kstep;
            const char* a3 = a2 + kstep; const char* b3 = b2 + kstep;
            if (last && has_next) S.a_ready(nxt);
            if constexpr (SP2) {
            PG8_LDB(B0, 0, 0); PG8_LDB(B1, 0, 1); PG8_SCHED; PG8_LDA(At, 0, 0); PG8_STAGE(PG8_SA(1, 1), a1 + hstep, voffA);
            PG8_WAIT_V(8); PG8_WAIT_L(0); PG8_BAR; PG8_MMA(0, 0, At, B0); PG8_MMA(0, 1, At, B1); PG8_BAR; PG8_SCHED;
            PG8_LDA(At, 0, 1); PG8_STAGE(PG8_SB(0, 0), b2, voffB); PG8_STAGE(PG8_SB(0, 1), b2 + hstep, voffB); PG8_STAGE(PG8_SA(0, 0), a2, voffA);
            PG8_WAIT_V(8); PG8_WAIT_L(0); PG8_BAR; PG8_MMA(1, 0, At, B0); PG8_MMA(1, 1, At, B1); PG8_BAR; PG8_SCHED;
            PG8_LDB(B0, 1, 0); PG8_LDB(B1, 1, 1); PG8_SCHED; PG8_LDA(At, 1, 0); PG8_STAGE(PG8_SA(0, 1), a2 + hstep, voffA);
            PG8_WAIT_V(8); PG8_WAIT_L(0); PG8_BAR; PG8_MMA(0, 0, At, B0); PG8_MMA(0, 1, At, B1); PG8_BAR; PG8_SCHED;
            PG8_LDA(At, 1, 1); PG8_STAGE(PG8_SB(1, 0), b3, voffB); PG8_STAGE(PG8_SB(1, 1), b3 + hstep, voffB); PG8_STAGE(PG8_SA(1, 0), a3, voffA);
            PG8_WAIT_V(8); PG8_WAIT_L(0); PG8_BAR; PG8_MMA(1, 0, At, B0); PG8_MMA(1, 1, At, B1); PG8_BAR; PG8_SCHED;
            } else {
            PG8_LDB(B0, 0, 0); PG8_SCHED; PG8_LDA(At, 0, 0); PG8_STAGE(PG8_SA(1, 1), a1 + hstep, voffA);
            PG8_WAIT_L(8); PG8_BAR; PG8_WAIT_L(0); PG8_MMA(0, 0, At, B0); PG8_BAR; PG8_SCHED;
            PG8_LDB(B1, 0, 1); PG8_STAGE(PG8_SB(0, 0), b2, voffB);
            PG8_BAR; PG8_WAIT_L(0); PG8_MMA(0, 1, At, B1); PG8_BAR;
            PG8_LDA(At, 0, 1); PG8_STAGE(PG8_SA(0, 0), a2, voffA);
            PG8_BAR; PG8_WAIT_L(0); PG8_MMA(1, 0, At, B0); PG8_BAR; PG8_SCHED;
            PG8_STAGE(PG8_SB(0, 1), b2 + hstep, voffB);
            PG8_WAIT_V(6); PG8_BAR; PG8_MMA(1, 1, At, B1); PG8_BAR;
            PG8_LDB(B0, 1, 0); PG8_SCHED; PG8_LDA(At, 1, 0); PG8_STAGE(PG8_SA(0, 1), a2 + hstep, voffA);
            PG8_WAIT_L(8); PG8_BAR; PG8_WAIT_L(0); PG8_MMA(0, 0, At, B0); PG8_BAR; PG8_SCHED;
            PG8_LDB(B1, 1, 1); PG8_STAGE(PG8_SB(1, 0), b3, voffB);
            PG8_BAR; PG8_WAIT_L(0); PG8_MMA(0, 1, At, B1); PG8_BAR;
            PG8_LDA(At, 1, 1); PG8_STAGE(PG8_SA(1, 0), a3, voffA);
            PG8_BAR; PG8_WAIT_L(0); PG8_MMA(1, 0, At, B0); PG8_BAR; PG8_SCHED;
            PG8_STAGE(PG8_SB(1, 1), b3 + hstep, voffB);
            PG8_WAIT_V(6); PG8_BAR; PG8_MMA(1, 1, At, B1); PG8_BAR;
            }
        }
        if constexpr (ALIGN_EPI) { if (wr == 0) PG8_BAR; }
        if constexpr (!Epi::AFTER_DRAIN) { E(acc, cur, wr, wc, fr, fq); S.done(cur); }
        if (!has_next) break;
#pragma unroll
        for (int a = 0; a < 2; ++a)
#pragma unroll
            for (int b = 0; b < 2; ++b)
#pragma unroll
                for (int m = 0; m < 4; ++m)
#pragma unroll
                    for (int n = 0; n < 2; ++n) acc[a][b][m][n] = (f32x4){0.f, 0.f, 0.f, 0.f};
        cur = nxt; cA = nA; cB = nB; ++ui;
        if constexpr (ALIGN_EPI) { if (wr == 1) PG8_BAR; }
    }
    PG8_WAIT_V(0);
    if constexpr (!ALIGN_EPI) { if (wr == 0) PG8_BAR; }
    PG8_BAR;
    if constexpr (Epi::AFTER_DRAIN) { E.fused(acc, cur, wr, wc, fr, fq, lds, wid, lane); S.done(cur); }
#undef PG8_SA
#undef PG8_SB
#undef PG8_STAGE
#undef PG8_LDA
#undef PG8_LDB
#undef PG8_MMA
#undef PG8_WAIT_V
#undef PG8_WAIT_L
#undef PG8_BAR
#undef PG8_SCHED
}
}

#define DI __device__ __forceinline__
#define LAS __attribute__((address_space(3)))
typedef unsigned short bf16;
typedef short bf16x8 __attribute__((ext_vector_type(8)));
typedef short s16x4 __attribute__((ext_vector_type(4)));
typedef float f32x4 __attribute__((ext_vector_type(4)));
typedef float f32x16 __attribute__((ext_vector_type(16)));
typedef unsigned u32x4 __attribute__((ext_vector_type(4)));
typedef unsigned u32x2 __attribute__((ext_vector_type(2)));
typedef __bf16 bf16x2_t __attribute__((ext_vector_type(2)));
typedef float f32x2_t __attribute__((ext_vector_type(2)));
typedef LAS unsigned char* ldsp;

DI unsigned pk2(float a, float b) { f32x2_t f = {a, b}; return __builtin_bit_cast(unsigned, __builtin_convertvector(f, bf16x2_t)); }
DI float bflo(unsigned w) { return __uint_as_float(w << 16); }
DI float bfhi(unsigned w) { return __uint_as_float(w & 0xffff0000u); }
DI unsigned short f2bf1(float a) { return (unsigned short)(pk2(a, 0.f) & 0xffffu); }
DI void unpack8(const u32x4 r, float (&f)[8]) { f[0] = bflo(r.x); f[1] = bfhi(r.x); f[2] = bflo(r.y); f[3] = bfhi(r.y); f[4] = bflo(r.z); f[5] = bfhi(r.z); f[6] = bflo(r.w); f[7] = bfhi(r.w); }
DI u32x4 pack8(const float (&f)[8]) { u32x4 r; r.x = pk2(f[0], f[1]); r.y = pk2(f[2], f[3]); r.z = pk2(f[4], f[5]); r.w = pk2(f[6], f[7]); return r; }
DI int opaque_tid() { int t = threadIdx.x; asm volatile("" : "+v"(t)); return t; }
DI float ex2(float x) { return __builtin_amdgcn_exp2f(x); }
DI float gelu_t(float x) { const float u = x * (1.f + 0.044715f * x * x); return x * __builtin_amdgcn_rcpf(1.f + ex2(-2.302208198f * u)); }
DI float silu_f(float x) { return x * __builtin_amdgcn_rcpf(1.f + ex2(-1.4426950409f * x)); }
DI float wave_sum(float v) {
#pragma unroll
    for (int o = 1; o < 64; o <<= 1) v += __shfl_xor(v, o);
    return v;
}
#define LDS_WAIT() asm volatile("s_waitcnt lgkmcnt(0)" ::: "memory")
#define MFMA16(a, b, c) __builtin_amdgcn_mfma_f32_16x16x32_bf16((a), (b), (c), 0, 0, 0)
#define MFMA32(a, b, c) __builtin_amdgcn_mfma_f32_32x32x16_bf16((a), (b), (c), 0, 0, 0)

constexpr int MTOK = 16384, DM = 1024, INW = 3072, DFF = 2816, UPW = 5632, NCTX = 8192;
constexpr float EPS = 1e-6f;
enum { I_XP = 0, I_XS, I_C, I_CK, I_CV, I_SRF, I_SRB, I_CCTX, I_N1, I_WMOD, I_BMOD, I_WIN, I_SGUN, I_SGUW, I_SGUB, I_RLF, I_RLB, I_RETN,
       I_QN, I_KN, I_DLAM, I_DN, I_WOUT, I_N2, I_FUP, I_FCONV, I_FCB, I_FDN, N_IN };
constexpr size_t O_Y = 0, O_CK = 16777216, O_CV = 25165824, O_RF = 33554432, O_RB = 34603008, O_END = 35651584;
constexpr size_t MiB = 1u << 20;
constexpr size_t WS_CTR = 0, WS_TAB = 64 * 1024, WS_MODS = 128 * 1024;
constexpr size_t WS_WIN = 2 * MiB, WS_WOUT = 8 * MiB, WS_WUP = 10 * MiB, WS_WDN = 21 * MiB;
constexpr size_t WS_H = 27 * MiB, WS_Z = 59 * MiB, WS_Q = 155 * MiB, WS_KCTX = 171 * MiB, WS_KSMP = 179 * MiB, WS_VTCTX = 189 * MiB, WS_VTSMP = 197 * MiB, WS_RS = 207 * MiB;
constexpr size_t WS_UP = 59 * MiB, WS_G = 147 * MiB, WS_END = 256 * MiB;
constexpr size_t WS_H2 = 203 * MiB;
constexpr size_t WS_SS = 1 * MiB, WS_SHW = 236 * MiB, WS_ZERO_BYTES = 1 * MiB + 3 * 65536;
constexpr size_t WS_WIN1 = 237 * MiB, WS_WOUT1 = 243 * MiB, WS_WUP1 = 245 * MiB;
constexpr size_t SHW_SET = 9 * 5632;

constexpr int LDS_MAIN = 131072, LDS_BYTES = LDS_MAIN + 1024;
constexpr int NPH = 23;

struct Params { const float* in[N_IN]; float* out; unsigned char* ws; int ph_lo, ph_hi, coop, pad; };

struct EpiResid {
    static constexpr bool PERM = false, AFTER_DRAIN = false;
    const float* x_ctx; const float* x_smp; float* out; const float* gate;
    __device__ __forceinline__ void operator()(const pg8::f32x4 (&acc)[2][2][4][2], const pg8::Unit& u, int wr, int wc, int fr, int fq) const {
        const int pm = u.pm; const int j = pm < 32 ? 0 : 1 + ((pm - 32) >> 2);
        const float* xs = pm < 32 ? x_ctx + (size_t)pm * 256 * DM : x_smp + (size_t)(pm - 32) * 256 * DM;
        float* o = out + (size_t)pm * 256 * DM;
        const int col0 = u.pn * 256 + wc * 32 + 4 * fq;
        pg8::f32x4 gv[2][2];
#pragma unroll
        for (int bj = 0; bj < 2; ++bj)
#pragma unroll
            for (int n = 0; n < 2; ++n) gv[bj][n] = *(const pg8::f32x4*)(gate + (size_t)j * 6144 + col0 + bj * 128 + n * 16);
#pragma unroll
        for (int ai = 0; ai < 2; ++ai)
#pragma unroll
            for (int m = 0; m < 4; ++m) { const size_t roff = (size_t)(ai * 128 + wr * 64 + m * 16 + fr) * DM + col0;
#pragma unroll
                for (int bj = 0; bj < 2; ++bj)
#pragma unroll
                    for (int n = 0; n < 2; ++n) { const size_t off = roff + bj * 128 + n * 16;
                        const pg8::f32x4 xv = *(const pg8::f32x4*)(xs + off); *(pg8::f32x4*)(o + off) = xv + gv[bj][n] * acc[ai][bj][m][n]; } }
    }
};

template <int MODE> struct EpiResidFold {
    static constexpr bool PERM = false, AFTER_DRAIN = false;
    const float* x_ctx; const float* x_smp; float* out; const float* gate; const float* nw; const float* scb; bf16* xp; float* SS;
    __device__ __forceinline__ void operator()(const pg8::f32x4 (&acc)[2][2][4][2], const pg8::Unit& u, int wr, int wc, int fr, int fq) const {
        const int pm = u.pm; const int j = pm < 32 ? 0 : 1 + ((pm - 32) >> 2);
        const float* xs = pm < 32 ? x_ctx + (size_t)pm * 256 * DM : x_smp + (size_t)(pm - 32) * 256 * DM;
        float* o = out + (size_t)pm * 256 * DM; bf16* xq = xp + (size_t)pm * 256 * DM;
        bf16* xb = (bf16*)(out + (pm < 32 ? O_CK + (size_t)(2 * pm + 1) * 131072 : O_CV + (size_t)(2 * (pm - 32) + 1) * 131072));
        const int col0 = u.pn * 256 + wc * 32 + 4 * fq;
#pragma unroll
        for (int ai = 0; ai < 2; ++ai)
#pragma unroll
            for (int m = 0; m < 4; ++m) { const int lrow = ai * 128 + wr * 64 + m * 16 + fr; const size_t roff = (size_t)lrow * DM + col0; float ssq = 0.f;
                pg8::f32x4 xv[2][2], gv[2][2];
#pragma unroll
                for (int bj = 0; bj < 2; ++bj)
#pragma unroll
                    for (int n = 0; n < 2; ++n) gv[bj][n] = *(const pg8::f32x4*)(gate + (size_t)j * 6144 + col0 + bj * 128 + n * 16);
#pragma unroll
                for (int bj = 0; bj < 2; ++bj)
#pragma unroll
                    for (int n = 0; n < 2; ++n) { if (MODE == 2) { const u32x2 r = *(const u32x2*)(xb + roff + bj * 128 + n * 16); xv[bj][n] = (pg8::f32x4){bflo(r.x), bfhi(r.x), bflo(r.y), bfhi(r.y)}; }
                        else xv[bj][n] = *(const pg8::f32x4*)(xs + roff + bj * 128 + n * 16); }
#pragma unroll
                for (int bj = 0; bj < 2; ++bj)
#pragma unroll
                    for (int n = 0; n < 2; ++n) { const size_t off = roff + bj * 128 + n * 16; const int c = col0 + bj * 128 + n * 16;
                        const pg8::f32x4 y = xv[bj][n] + gv[bj][n] * acc[ai][bj][m][n];
                        if (MODE == 1) { u32x2 yb; yb.x = pk2(y[0], y[1]); yb.y = pk2(y[2], y[3]); *(u32x2*)(xb + off) = yb; } else *(pg8::f32x4*)(o + off) = y;
                        ssq += (y[0] * y[0] + y[1] * y[1]) + (y[2] * y[2] + y[3] * y[3]);
                        const pg8::f32x4 av = *(const pg8::f32x4*)(nw + c) * (*(const pg8::f32x4*)(scb + (size_t)j * 6144 + c) + 1.f);
                        const pg8::f32x4 q = y * av; u32x2 w; w.x = pk2(q[0], q[1]); w.y = pk2(q[2], q[3]); *(u32x2*)(xq + off) = w; }
                ssq += __shfl_xor(ssq, 16); ssq += __shfl_xor(ssq, 32);
                if (fq == 0) __hip_atomic_fetch_add(SS + (size_t)pm * 256 + lrow, ssq, __ATOMIC_RELAXED, __HIP_MEMORY_SCOPE_AGENT);
                asm volatile("" ::: "memory"); }
    }
};
struct EpiBf16Fold {
    static constexpr bool PERM = true, AFTER_DRAIN = false;
    bf16* O; int ldc; const float* SS; const float* bias; int N; int pm_off;
    __device__ __forceinline__ void operator()(const pg8::f32x4 (&acc)[2][2][4][2], const pg8::Unit& u, int wr, int wc, int fr, int fq) const {
        const int gpm = u.pm + pm_off; const int j = gpm < 32 ? 0 : 1 + ((gpm - 32) >> 2);
        const int row0 = u.pm * 256 + wr * 64 + fr, col0 = u.pn * 256 + wc * 32 + 8 * fq;
        pg8::f32x4 bv[2][2];
#pragma unroll
        for (int bj = 0; bj < 2; ++bj)
#pragma unroll
            for (int n = 0; n < 2; ++n) bv[bj][n] = *(const pg8::f32x4*)(bias + (size_t)j * N + col0 + bj * 128 + 4 * n);
        float rs[2][4];
#pragma unroll
        for (int ai = 0; ai < 2; ++ai)
#pragma unroll
            for (int m = 0; m < 4; ++m) rs[ai][m] = SS[(size_t)(row0 + ai * 128 + m * 16) + (size_t)pm_off * 256];
#pragma unroll
        for (int ai = 0; ai < 2; ++ai)
#pragma unroll
            for (int m = 0; m < 4; ++m) { const int lrow = row0 + ai * 128 + m * 16; const float rstd = rsqrtf(rs[ai][m] * (1.f / DM) + EPS);
                bf16* rowp = O + (size_t)lrow * ldc + col0;
#pragma unroll
                for (int bj = 0; bj < 2; ++bj) { const pg8::f32x4 v0 = acc[ai][bj][m][0] * rstd + bv[bj][0], v1 = acc[ai][bj][m][1] * rstd + bv[bj][1];
                    u32x4 w; w.x = pk2(v0[0], v0[1]); w.y = pk2(v0[2], v0[3]); w.z = pk2(v1[0], v1[1]); w.w = pk2(v1[2], v1[3]);
                    *(u32x4*)(rowp + bj * 128) = w; } }
    }
};

template <typename T> DI float ld_as_f32(const T* p);
template <> DI float ld_as_f32<float>(const float* p) { return *p; }
template <> DI float ld_as_f32<bf16>(const bf16* p) { return __uint_as_float((unsigned)(*p) << 16); }
template <typename T> DI void tr_item(const T* src, size_t ld_s, bf16* dst, size_t ld_d, LAS float* scr, int lane) {
    if constexpr (sizeof(T) == 4) {
        f32x4 v[8]; const int rr = lane >> 3, c4 = (lane & 7) * 4;
#pragma unroll
        for (int i = 0; i < 8; ++i) v[i] = *(const f32x4*)((const float*)src + (size_t)(8 * i + rr) * ld_s + c4);
#pragma unroll
        for (int i = 0; i < 8; ++i) { LAS float* d = scr + (8 * i + rr) * 33 + c4; d[0] = v[i][0]; d[1] = v[i][1]; d[2] = v[i][2]; d[3] = v[i][3]; }
    } else {
#pragma unroll 8
        for (int i = 0; i < 32; ++i) { const int kk = 2 * i + (lane >> 5); scr[kk * 33 + (lane & 31)] = ld_as_f32<T>(src + (size_t)kk * ld_s + (lane & 31)); }
    }
    LDS_WAIT();
    const int c = lane & 7;
#pragma unroll
    for (int j = 0; j < 4; ++j) { const int n = (lane >> 3) + 8 * j; const LAS float* s = scr + (8 * c) * 33 + n;
        u32x4 o; o.x = pk2(s[0 * 33], s[1 * 33]); o.y = pk2(s[2 * 33], s[3 * 33]); o.z = pk2(s[4 * 33], s[5 * 33]); o.w = pk2(s[6 * 33], s[7 * 33]);
        *(u32x4*)(dst + (size_t)n * ld_d + 8 * c) = o; }
    LDS_WAIT();
}

DI void gemv9_unit(ldsp lds, const float* v0, const float* v1, int vstride, bool act, const float* W, int N, const float* bvec, float* out, int n0, int ncols = 64) {
    LAS float* S = (LAS float*)lds;
    LAS float* RED = (LAS float*)(lds + 9 * 1024 * 4);
    const int tid = opaque_tid();
    for (int i = tid; i < 9 * 1024; i += 512) { const int j = i >> 10, k = i & 1023; const float v = j == 0 ? v0[k] : v1[(size_t)(j - 1) * vstride + k]; S[i] = act ? silu_f(v) : v; }
    __syncthreads();
    const int cq = tid & 15, kg = tid >> 4; const bool act_col = 4 * cq < ncols;
    const float* w = W + ((size_t)kg * 32) * N + n0 + (act_col ? 4 * cq : 0);
    f32x4 acc[9];
#pragma unroll
    for (int j = 0; j < 9; ++j) acc[j] = (f32x4){0.f, 0.f, 0.f, 0.f};
#pragma unroll 1
    for (int k0 = 0; k0 < 32; k0 += 8) {
        f32x4 wv[8];
#pragma unroll
        for (int k = 0; k < 8; ++k) wv[k] = *(const f32x4*)(w + (size_t)(k0 + k) * N);
#pragma unroll
        for (int k = 0; k < 8; ++k)
#pragma unroll
            for (int j = 0; j < 9; ++j) acc[j] += wv[k] * S[j * 1024 + kg * 32 + k0 + k];
    }
#pragma unroll
    for (int j = 0; j < 9; ++j) *(LAS f32x4*)(RED + (kg * 9 + j) * 64 + 4 * cq) = acc[j];
    __syncthreads();
    for (int o = tid; o < 576; o += 512) { const int j = o >> 6, cc = o & 63; if (cc >= ncols) continue; float sm = bvec ? bvec[n0 + cc] : 0.f;
#pragma unroll 8
        for (int g = 0; g < 32; ++g) sm += RED[(g * 9 + j) * 64 + cc];
        out[(size_t)j * N + n0 + cc] = sm; }
    __syncthreads();
}
DI void phase_mods(const Params& P, ldsp lds) {
    float* mods = (float*)(P.ws + WS_MODS);
    for (int u = blockIdx.x; u < 256; u += gridDim.x) { const int l = u / 128, n0 = (u % 128) * 48;
        gemv9_unit(lds, P.in[I_CCTX], P.in[I_C], 1024, true, P.in[I_WMOD] + (size_t)l * 1024 * 6144, 6144, P.in[I_BMOD] + l * 6144, mods + (size_t)l * 9 * 6144, n0, 48); }
}
DI void phase_shw(const Params& P, ldsp lds) {
    const float* mods = (const float*)(P.ws + WS_MODS); float* shw = (float*)(P.ws + WS_SHW);
    for (int u = blockIdx.x; u < 224; u += gridDim.x) {
        if (u < 88) gemv9_unit(lds, mods + 3072, mods + 6144 + 3072, 6144, false, P.in[I_FUP], 5632, nullptr, shw, u * 64);
        else if (u < 136) gemv9_unit(lds, mods + 9 * 6144, mods + 10 * 6144, 6144, false, P.in[I_WIN] + (size_t)1024 * 3072, 3072, nullptr, shw + SHW_SET, (u - 88) * 64);
        else gemv9_unit(lds, mods + 9 * 6144 + 3072, mods + 10 * 6144 + 3072, 6144, false, P.in[I_FUP] + (size_t)1024 * 5632, 5632, nullptr, shw + 2 * SHW_SET, (u - 136) * 64);
    }
}
DI void phase_tables(const Params& P) {
    if (blockIdx.x != 0) return;
    const int tid = opaque_tid();
    float* tab = (float*)(P.ws + WS_TAB);
    for (int i = tid; i < 1024; i += 512) {
        const int pos = i >> 4, fi = i & 15;
        const float inv = exp2f(-(float)fi * (13.287712379549449f / 16.f));
        const float angf = (float)pos * inv;
        double x = (double)angf; const double kk = rint(x * 0.15915494309189535); x -= kk * 6.283185307179586;
        const double x2 = x * x; double ts = x, sn = x, tc = 1.0, cs = 1.0;
#pragma unroll 1
        for (int n = 1; n <= 14; ++n) { ts *= -x2 / (double)((2 * n) * (2 * n + 1)); sn += ts; tc *= -x2 / (double)((2 * n - 1) * (2 * n)); cs += tc; }
        tab[i * 2] = (float)cs; tab[i * 2 + 1] = (float)sn;
    }
}
DI void phase_prep(const Params& P, int l, ldsp lds, int mask, int blk0 = 0, int nblk = 0, int par = -1) {
    const int tid = opaque_tid(), lane = tid & 63, wid = tid >> 6;
    const int gw = ((int)blockIdx.x - blk0) * 8 + wid, NGW = (nblk ? nblk : (int)gridDim.x) * 8;
    LAS float* scr = (LAS float*)(lds + wid * 16384);
    constexpr int I1 = 16 * 96, I2 = 16 * 32, I3 = 16 * 176, I4 = 44 * 32, I5 = 512;
    const float* w_in = P.in[I_WIN] + (size_t)l * 1024 * 3072; const float* w_out = P.in[I_WOUT] + (size_t)l * 1024 * 1024;
    const float* w_up = P.in[I_FUP] + (size_t)l * 1024 * 5632; const float* w_dn = P.in[I_FDN] + (size_t)l * 2816 * 1024;
    bf16* win_t = (bf16*)(P.ws + (l ? WS_WIN1 : WS_WIN)); bf16* wout_t = (bf16*)(P.ws + (l ? WS_WOUT1 : WS_WOUT)); bf16* wup_t = (bf16*)(P.ws + (l ? WS_WUP1 : WS_WUP));
    if (mask & 1) for (int it = gw; it < I1 + I2 + I3; it += NGW) {
        int r = it; if (par >= 0 && ((it / NGW) & 1) != par) continue;
        if (r < I1) { const int kb = r / 96, nb = r % 96; tr_item<float>(w_in + (size_t)(64 * kb) * 3072 + 32 * nb, 3072, win_t + (size_t)(32 * nb) * 1024 + 64 * kb, 1024, scr, lane); continue; } r -= I1;
        if (r < I2) { const int kb = r / 32, nb = r % 32; tr_item<float>(w_out + (size_t)(64 * kb) * 1024 + 32 * nb, 1024, wout_t + (size_t)(32 * nb) * 1024 + 64 * kb, 1024, scr, lane); continue; } r -= I2;
        { const int kb = r / 176, nb = r % 176; tr_item<float>(w_up + (size_t)(64 * kb) * 5632 + 32 * nb, 5632, wup_t + (size_t)(32 * nb) * 1024 + 64 * kb, 1024, scr, lane); }
    }
    if (mask & 2) for (int r = gw; r < I4; r += NGW) { const int kb = r / 32, nb = r % 32; tr_item<float>(w_dn + (size_t)(64 * kb) * 1024 + 32 * nb, 1024, (bf16*)(P.ws + WS_WDN) + (size_t)(32 * nb) * 2816 + 64 * kb, 2816, scr, lane); }
    if (mask & 4) {
        for (int r = gw; r < I5; r += NGW) { const int b = r >> 6, rem = r & 63, keyblk = rem >> 4, cb = rem & 15;
            tr_item<float>(P.in[I_CV] + ((size_t)(b * 2 + l) * 256 + 64 * keyblk) * 512 + 32 * cb, 512, (bf16*)(P.ws + WS_VTSMP) + ((size_t)b * 512 + 32 * cb) * 1280 + 64 * keyblk, 1280, scr, lane); }
        bf16* ksmp = (bf16*)(P.ws + WS_KSMP);
        for (int i = blockIdx.x * 512 + tid; i < 131072; i += gridDim.x * 512) {
            const int e0 = i * 8, b = e0 >> 17, rem = e0 & 131071, key = rem >> 9, col = rem & 511, h = col >> 7, c128 = col & 127;
            const float* src = P.in[I_CK] + ((size_t)(b * 2 + l) * 256 + key) * 512 + col;
            const f32x4 a = *(const f32x4*)src, c = *(const f32x4*)(src + 4);
            u32x4 o; o.x = pk2(a[0], a[1]); o.y = pk2(a[2], a[3]); o.z = pk2(c[0], c[1]); o.w = pk2(c[2], c[3]);
            *(u32x4*)(ksmp + ((size_t)(b * 4 + h) * 1280 + key) * 128 + c128) = o;
        }
    }
}
DI void phase_norm(const Params& P, const float* __restrict__ x_ctx, const float* __restrict__ x_smp, const float* __restrict__ nw, const float* __restrict__ mods_l, int sh_off, int sc_off) {
    const int tid = opaque_tid(), lane = tid & 63, wid = tid >> 6;
    const int gw = blockIdx.x * 8 + wid, NGW = gridDim.x * 8;
    bf16* __restrict__ H = (bf16*)(P.ws + WS_H);
    for (int mb = gw; mb < MTOK; mb += 4 * NGW) {
        f32x4 v[4][4];
#pragma unroll
        for (int r = 0; r < 4; ++r) { const int m = mb + r * NGW;
            if (m < MTOK) { const float* xr = m < NCTX ? x_ctx + (size_t)m * DM : x_smp + (size_t)(m - NCTX) * DM;
#pragma unroll
                for (int q = 0; q < 4; ++q) v[r][q] = *((const f32x4*)xr + lane + 64 * q); } }
#pragma unroll
        for (int r = 0; r < 4; ++r) { const int m = mb + r * NGW;
            if (m < MTOK) {
                const int j = m < NCTX ? 0 : 1 + ((m - NCTX) >> 10);
                const float* md = mods_l + (size_t)j * 6144;
                float ss = 0.f;
#pragma unroll
                for (int q = 0; q < 4; ++q) ss += (v[r][q][0] * v[r][q][0] + v[r][q][1] * v[r][q][1]) + (v[r][q][2] * v[r][q][2] + v[r][q][3] * v[r][q][3]);
                const float rstd = rsqrtf(wave_sum(ss) * (1.f / DM) + EPS);
#pragma unroll
                for (int q = 0; q < 4; ++q) { const int col = 4 * (lane + 64 * q);
                    const f32x4 w = *(const f32x4*)(nw + col), sc = *(const f32x4*)(md + sc_off + col), sh = *(const f32x4*)(md + sh_off + col);
                    const f32x4 y = (v[r][q] * rstd) * w * (sc + 1.f) + sh;
                    u32x2 o; o.x = pk2(y[0], y[1]); o.y = pk2(y[2], y[3]);
                    *(u32x2*)(H + (size_t)m * DM + col) = o; } } }
    }
}
DI int next_unit(unsigned* ctr, ldsp lds) {
    LAS int* slot = (LAS int*)(lds + LDS_MAIN);
    __syncthreads();
    if (opaque_tid() == 0) *slot = (int)atomicAdd(ctr, 1u);
    __syncthreads();
    return *slot;
}
DI void sgu_unit(const Params& P, int l, int ck, ldsp lds, int gh) {
    const int tid = opaque_tid(), lane = tid & 63, wid = tid >> 6, fr = lane & 15, fq = lane >> 4;
    const bf16* Z = (const bf16*)(P.ws + WS_Z); bf16* YC = (bf16*)(P.ws + WS_H);
    const size_t m0 = (size_t)ck * 128;
    ldsp VnT = lds; ldsp WsL = lds + 256 * 272;
    const float* gn = P.in[I_SGUN] + l * 256;
    {   const int cc = tid & 31, r0 = tid >> 5;
        float gnv[8];
#pragma unroll
        for (int e = 0; e < 8; ++e) gnv[e] = gn[8 * cc + e];
        u32x4 raws[8];
#pragma unroll
        for (int i = 0; i < 8; ++i) raws[i] = *(const u32x4*)(Z + (m0 + r0 + 16 * i) * INW + 256 + 8 * cc);
#pragma unroll
        for (int i = 0; i < 8; ++i) { const int q = r0 + 16 * i;
            const u32x4 raw = raws[i];
            float f[8]; unpack8(raw, f); float ss = 0.f;
#pragma unroll
            for (int e = 0; e < 8; ++e) { f[e] = gelu_t(f[e]); ss += f[e] * f[e]; }
            ss += __shfl_xor(ss, 1); ss += __shfl_xor(ss, 2); ss += __shfl_xor(ss, 4); ss += __shfl_xor(ss, 8); ss += __shfl_xor(ss, 16);
            const float rstd = rsqrtf(ss * (1.f / 256.f) + EPS);
            if ((cc >> 4) == gh) {
#pragma unroll
                for (int e = 0; e < 8; ++e) *(LAS bf16*)(VnT + (8 * cc + e) * 272 + (q ^ ((cc & 7) << 3)) * 2) = f2bf1(f[e] * rstd * gnv[e]); }
        }
    }
    f32x4 wpre[8];
    {   const f32x4* ws_g = (const f32x4*)(P.in[I_SGUW] + ((size_t)(l * 4 + 2 * gh) * 128) * 128);
#pragma unroll
        for (int i = 0; i < 8; ++i) wpre[i] = ws_g[tid + 512 * i]; }
    for (int g = 2 * gh; g < 2 * gh + 2; ++g) {
#pragma unroll
        for (int i = 0; i < 8; ++i) { const int idx = tid + 512 * i, p = idx >> 5, q4 = idx & 31;
            u32x2 o; o.x = pk2(wpre[i][0], wpre[i][1]); o.y = pk2(wpre[i][2], wpre[i][3]);
            *(LAS u32x2*)(WsL + p * 272 + q4 * 8) = o; }
        __syncthreads();
        if (g < 2 * gh + 1) { const f32x4* ws_g = (const f32x4*)(P.in[I_SGUW] + ((size_t)(l * 4 + g + 1) * 128) * 128);
#pragma unroll
            for (int i = 0; i < 8; ++i) wpre[i] = ws_g[tid + 512 * i]; }
        const int p = 16 * wid + fr; const float bias = P.in[I_SGUB][(l * 4 + g) * 128 + p];
        u32x2 zu[4];
#pragma unroll
        for (int mi = 0; mi < 4; ++mi) zu[mi] = *(const u32x2*)(Z + (m0 + p) * INW + 64 * g + 16 * mi + 4 * fq);
        f32x4 acc[4];
#pragma unroll
        for (int mi = 0; mi < 4; ++mi) acc[mi] = (f32x4){0.f, 0.f, 0.f, 0.f};
#pragma unroll
        for (int ks = 0; ks < 4; ++ks) { const bf16x8 bw = *(const LAS bf16x8*)(WsL + (16 * wid + fr) * 272 + (32 * ks + 8 * fq) * 2);
#pragma unroll
            for (int mi = 0; mi < 4; ++mi) { const bf16x8 av = *(const LAS bf16x8*)(VnT + (64 * g + 16 * mi + fr) * 272 + ((32 * ks + 8 * fq) ^ (((2 * mi + (fr >> 3)) & 7) << 3)) * 2); acc[mi] = MFMA16(av, bw, acc[mi]); } }
#pragma unroll
        for (int mi = 0; mi < 4; ++mi) { const int c0 = 64 * g + 16 * mi + 4 * fq;
            const float y0 = gelu_t(bflo(zu[mi].x)) * (acc[mi][0] + bias), y1 = gelu_t(bfhi(zu[mi].x)) * (acc[mi][1] + bias), y2 = gelu_t(bflo(zu[mi].y)) * (acc[mi][2] + bias), y3 = gelu_t(bfhi(zu[mi].y)) * (acc[mi][3] + bias);
            u32x2 o; o.x = pk2(y0, y1); o.y = pk2(y2, y3);
            *(u32x2*)(YC + (m0 + p) * DM + c0) = o; }
        __syncthreads();
    }
}
DI float log2_sigmoid(float x) { return -log1pf(__expf(-x)) * 1.4426950408889634f; }
DI void rets_unit(const Params& P, int l, int ru, ldsp lds) {
    const int tid = opaque_tid(), lane = tid & 63, wid = tid >> 6, fr = lane & 15, fq = lane >> 4;
    const bf16* Z = (const bf16*)(P.ws + WS_Z); float* RS = (float*)(P.ws + WS_RS);
    const int gck = ru >> 2, h = ru & 3; const size_t m0 = (size_t)gck * 128;
    const float lgf = log2_sigmoid(P.in[I_RLF][l * 4 + h]), lgb = log2_sigmoid(P.in[I_RLB][l * 4 + h]);
    ldsp KfT = lds, KbT = lds + 17408, VT = lds + 34816;
    {   const int cc = tid & 7, pr = tid >> 3;
#pragma unroll
        for (int i = 0; i < 2; ++i) { const int p = pr + 64 * i;
            const u32x4 kr = *(const u32x4*)(Z + (m0 + p) * INW + 768 + 64 * h + 8 * cc), vr = *(const u32x4*)(Z + (m0 + p) * INW + 1024 + 64 * h + 8 * cc);
            float kf[8], vf[8]; unpack8(kr, kf); unpack8(vr, vf);
            const float df = ex2((float)(127 - p) * lgf) * 0.125f, db = ex2((float)p * lgb) * 0.125f;
#pragma unroll
            for (int e = 0; e < 8; ++e) { const int d = 8 * cc + e;
                const int ps = (p ^ ((cc & 3) << 3)) * 2;
                *(LAS bf16*)(KfT + d * 272 + ps) = f2bf1(kf[e] * df); *(LAS bf16*)(KbT + d * 272 + ps) = f2bf1(kf[e] * db); *(LAS bf16*)(VT + d * 272 + ps) = f2bf1(vf[e]); } }
    }
    __syncthreads();
    const int dir = wid >> 2, dblk = wid & 3; ldsp KT = dir ? KbT : KfT;
    f32x4 acc[4];
#pragma unroll
    for (int mi = 0; mi < 4; ++mi) acc[mi] = (f32x4){0.f, 0.f, 0.f, 0.f};
#pragma unroll
    for (int ks = 0; ks < 4; ++ks) { const bf16x8 bk = *(const LAS bf16x8*)(KT + (16 * dblk + fr) * 272 + (32 * ks + 8 * (fq ^ ((2 * dblk + (fr >> 3)) & 3))) * 2);
#pragma unroll
        for (int mi = 0; mi < 4; ++mi) { const bf16x8 av = *(const LAS bf16x8*)(VT + (16 * mi + fr) * 272 + (32 * ks + 8 * (fq ^ ((2 * mi + (fr >> 3)) & 3))) * 2); acc[mi] = MFMA16(av, bk, acc[mi]); } }
    float* dst = RS + ((size_t)ru * 2 + dir) * 4096 + (16 * dblk + fr) * 64;
#pragma unroll
    for (int mi = 0; mi < 4; ++mi) *(f32x4*)(dst + 16 * mi + 4 * fq) = acc[mi];
}
DI void reto_unit(const Params& P, int l, int ru, ldsp lds) {
    const int tid = opaque_tid(), lane = tid & 63, wid = tid >> 6, fr = lane & 15, fq = lane >> 4;
    const bf16* Z = (const bf16*)(P.ws + WS_Z); const float* RS = (const float*)(P.ws + WS_RS); bf16* YC = (bf16*)(P.ws + WS_H);
    const int gck = ru >> 2, h = ru & 3; const size_t m0 = (size_t)gck * 128;
    const bool ctx = gck < 64;
    const int b = ctx ? (gck >> 1) : ((gck - 64) >> 3), n = ctx ? (gck & 1) : ((gck - 64) & 7), N = ctx ? 2 : 8;
    const float lgf = log2_sigmoid(P.in[I_RLF][l * 4 + h]), lgb = log2_sigmoid(P.in[I_RLB][l * 4 + h]);
    const float Gf = ex2(128.f * lgf), Gb = ex2(128.f * lgb);
    ldsp QL = lds, KL = lds + 18432, VT = lds + 36864, RfT = lds + 54272, RbT = lds + 63488;
    u32x4 qkv[2][3];
    {   const int cc = tid & 7, pr = tid >> 3;
#pragma unroll
        for (int i = 0; i < 2; ++i) { const bf16* zr = Z + (m0 + pr + 64 * i) * INW + 64 * h + 8 * cc; qkv[i][0] = *(const u32x4*)(zr + 512); qkv[i][1] = *(const u32x4*)(zr + 768); qkv[i][2] = *(const u32x4*)(zr + 1024); } }
    {
        const int d = tid >> 3, e0 = (tid & 7) * 8;
        float rf[8], rb[8];
        if (ctx) {
#pragma unroll
            for (int e = 0; e < 8; ++e) { rf[e] = 0.f; rb[e] = 0.f; }
        } else {
            const float* sf = P.in[I_SRF] + ((size_t)((b * 2 + l) * 4 + h)) * 4096 + d * 64 + e0; const float* sb = P.in[I_SRB] + ((size_t)((b * 2 + l) * 4 + h)) * 4096 + d * 64 + e0;
#pragma unroll
            for (int e = 0; e < 8; ++e) { rf[e] = sf[e]; rb[e] = sb[e]; }
        }
        {   f32x4 sv[7][2];
#pragma unroll
            for (int m = 0; m < 7; ++m) if (m < n) { const float* s = RS + ((size_t)(((gck - n + m) << 2) | h) * 2 + 0) * 4096 + d * 64 + e0; sv[m][0] = *(const f32x4*)s; sv[m][1] = *(const f32x4*)(s + 4); }
#pragma unroll
            for (int m = 0; m < 7; ++m) if (m < n) {
#pragma unroll
                for (int e = 0; e < 8; ++e) rf[e] = rf[e] * Gf + sv[m][e >> 2][e & 3]; }
        }
        {   f32x4 sv[7][2];
#pragma unroll
            for (int q = 0; q < 7; ++q) { const int m = N - 1 - q; if (m > n) { const float* s = RS + ((size_t)(((gck - n + m) << 2) | h) * 2 + 1) * 4096 + d * 64 + e0; sv[q][0] = *(const f32x4*)s; sv[q][1] = *(const f32x4*)(s + 4); } }
#pragma unroll
            for (int q = 0; q < 7; ++q) { const int m = N - 1 - q; if (m > n) {
#pragma unroll
                for (int e = 0; e < 8; ++e) rb[e] = rb[e] * Gb + sv[q][e >> 2][e & 3]; } }
        }
#pragma unroll
        for (int e = 0; e < 8; ++e) { const int ds = (d ^ (((tid & 7) & 3) << 3)) * 2; *(LAS bf16*)(RfT + (e0 + e) * 144 + ds) = f2bf1(rf[e]); *(LAS bf16*)(RbT + (e0 + e) * 144 + ds) = f2bf1(rb[e]); }
        if (ctx && n == N - 1) { const float* s = RS + ((size_t)ru * 2 + 0) * 4096 + d * 64 + e0; float* o = P.out + O_RF + ((size_t)((b * 2 + l) * 4 + h)) * 4096 + d * 64 + e0;
#pragma unroll
            for (int e = 0; e < 8; ++e) o[e] = rf[e] * Gf + s[e]; }
        if (ctx && n == 0) { const float* s = RS + ((size_t)ru * 2 + 1) * 4096 + d * 64 + e0; float* o = P.out + O_RB + ((size_t)((b * 2 + l) * 4 + h)) * 4096 + d * 64 + e0;
#pragma unroll
            for (int e = 0; e < 8; ++e) o[e] = rb[e] * Gb + s[e]; }
    }
    {   const int cc = tid & 7, pr = tid >> 3;
#pragma unroll
        for (int i = 0; i < 2; ++i) { const int p = pr + 64 * i;
            const u32x4 qr = qkv[i][0], kr = qkv[i][1], vr = qkv[i][2];
            *(LAS u32x4*)(QL + p * 144 + 16 * cc) = qr; *(LAS u32x4*)(KL + p * 144 + 16 * cc) = kr;
            *(LAS bf16*)(VT + (8 * cc + 0) * 272 + p * 2) = (bf16)(vr.x & 0xffffu); *(LAS bf16*)(VT + (8 * cc + 1) * 272 + p * 2) = (bf16)(vr.x >> 16);
            *(LAS bf16*)(VT + (8 * cc + 2) * 272 + p * 2) = (bf16)(vr.y & 0xffffu); *(LAS bf16*)(VT + (8 * cc + 3) * 272 + p * 2) = (bf16)(vr.y >> 16);
            *(LAS bf16*)(VT + (8 * cc + 4) * 272 + p * 2) = (bf16)(vr.z & 0xffffu); *(LAS bf16*)(VT + (8 * cc + 5) * 272 + p * 2) = (bf16)(vr.z >> 16);
            *(LAS bf16*)(VT + (8 * cc + 6) * 272 + p * 2) = (bf16)(vr.w & 0xffffu); *(LAS bf16*)(VT + (8 * cc + 7) * 272 + p * 2) = (bf16)(vr.w >> 16); }
    }
    __syncthreads();
    bf16x8 qfr[2];
#pragma unroll
    for (int ks = 0; ks < 2; ++ks) qfr[ks] = *(const LAS bf16x8*)(QL + (16 * wid + fr) * 144 + (32 * ks + 8 * fq) * 2);
    f32x4 a1[8];
#pragma unroll
    for (int jb = 0; jb < 8; ++jb) { a1[jb] = (f32x4){0.f, 0.f, 0.f, 0.f};
#pragma unroll
        for (int ks = 0; ks < 2; ++ks) { const bf16x8 kf = *(const LAS bf16x8*)(KL + (16 * jb + fr) * 144 + (32 * ks + 8 * fq) * 2); a1[jb] = MFMA16(kf, qfr[ks], a1[jb]); } }
    const int pl = 16 * wid + fr;
#pragma unroll
    for (int jb = 0; jb < 8; ++jb)
#pragma unroll
        for (int r = 0; r < 4; ++r) { const int dl = pl - (16 * jb + 4 * fq + r);
            const float fdl = (float)dl;
            const float D = ex2(fmaxf(fdl, 0.f) * lgf + fmaxf(-fdl, 0.f) * lgb) + fmaxf(1.f - fabsf(fdl), 0.f);
            a1[jb][r] *= D * 0.125f; }
    f32x4 a2[4], aF[4], aB[4];
#pragma unroll
    for (int eb = 0; eb < 4; ++eb) { a2[eb] = (f32x4){0.f, 0.f, 0.f, 0.f}; aF[eb] = a2[eb]; aB[eb] = a2[eb]; }
#pragma unroll
    for (int k2 = 0; k2 < 4; ++k2) {
        u32x4 pw; pw.x = pk2(a1[2 * k2][0], a1[2 * k2][1]); pw.y = pk2(a1[2 * k2][2], a1[2 * k2][3]); pw.z = pk2(a1[2 * k2 + 1][0], a1[2 * k2 + 1][1]); pw.w = pk2(a1[2 * k2 + 1][2], a1[2 * k2 + 1][3]);
        const bf16x8 pb = __builtin_bit_cast(bf16x8, pw);
#pragma unroll
        for (int eb = 0; eb < 4; ++eb) { const s16x4 lo = *(const LAS s16x4*)(VT + (16 * eb + fr) * 272 + (32 * k2 + 4 * fq) * 2), hi = *(const LAS s16x4*)(VT + (16 * eb + fr) * 272 + (32 * k2 + 16 + 4 * fq) * 2);
            const bf16x8 va = __builtin_shufflevector(lo, hi, 0, 1, 2, 3, 4, 5, 6, 7); a2[eb] = MFMA16(va, pb, a2[eb]); }
    }
#pragma unroll
    for (int ks = 0; ks < 2; ++ks)
#pragma unroll
        for (int eb = 0; eb < 4; ++eb) { const int rx = (32 * ks + 8 * fq) ^ (((2 * eb + (fr >> 3)) & 3) << 3); const bf16x8 rfv = *(const LAS bf16x8*)(RfT + (16 * eb + fr) * 144 + rx * 2), rbv = *(const LAS bf16x8*)(RbT + (16 * eb + fr) * 144 + rx * 2);
            aF[eb] = MFMA16(rfv, qfr[ks], aF[eb]); aB[eb] = MFMA16(rbv, qfr[ks], aB[eb]); }
    const float qdf = ex2((float)(pl + 1) * lgf), qdb = ex2((float)(128 - pl) * lgb);
    float ss = 0.f;
#pragma unroll
    for (int eb = 0; eb < 4; ++eb) { a2[eb] = a2[eb] + aF[eb] * qdf + aB[eb] * qdb; ss += (a2[eb][0] * a2[eb][0] + a2[eb][1] * a2[eb][1]) + (a2[eb][2] * a2[eb][2] + a2[eb][3] * a2[eb][3]); }
    ss += __shfl_xor(ss, 16); ss += __shfl_xor(ss, 32);
    const float rstd = rsqrtf(ss * (1.f / 64.f) + EPS);
    const float* rn = P.in[I_RETN] + (l * 4 + h) * 64;
#pragma unroll
    for (int eb = 0; eb < 4; ++eb) { const int e0 = 16 * eb + 4 * fq;
        const u32x2 gr = *(const u32x2*)(Z + (m0 + pl) * INW + 1280 + 64 * h + e0); const f32x4 w = *(const f32x4*)(rn + e0);
        const float y0 = a2[eb][0] * rstd * w[0] * silu_f(bflo(gr.x)), y1 = a2[eb][1] * rstd * w[1] * silu_f(bfhi(gr.x)), y2 = a2[eb][2] * rstd * w[2] * silu_f(bflo(gr.y)), y3 = a2[eb][3] * rstd * w[3] * silu_f(bfhi(gr.y));
        u32x2 o; o.x = pk2(y0, y1); o.y = pk2(y2, y3);
        *(u32x2*)(YC + (m0 + pl) * DM + 256 + 64 * h + e0) = o; }
}
DI void cprep_unit(const Params& P, int l, int cu, ldsp lds) {
    const int tid = opaque_tid();
    const bf16* Z = (const bf16*)(P.ws + WS_Z); bf16* Q = (bf16*)(P.ws + WS_Q); const float* tab = (const float*)(P.ws + WS_TAB);
    const int m0 = cu * 64; const bool ctx = m0 < NCTX;
    const int b = ctx ? (m0 >> 8) : ((m0 - NCTX) >> 10), t0 = ctx ? (m0 & 255) : ((m0 - NCTX) & 1023);
    {   const int c = tid & 7, gs = tid >> 3;
        u32x4 raws[16];
#pragma unroll
        for (int i = 0; i < 16; ++i) { const int item = gs + 64 * i, tok = item >> 4, grp = item & 15; raws[i] = *(const u32x4*)(Z + (size_t)(m0 + tok) * INW + 1536 + grp * 64 + 8 * c); }
#pragma unroll
        for (int i = 0; i < 16; ++i) { const int item = gs + 64 * i, tok = item >> 4, grp = item & 15, m = m0 + tok, t = t0 + tok;
            const u32x4 raw = raws[i];
            float f[8]; unpack8(raw, f); float ss = 0.f;
#pragma unroll
            for (int e = 0; e < 8; ++e) ss += f[e] * f[e];
            ss += __shfl_xor(ss, 1); ss += __shfl_xor(ss, 2); ss += __shfl_xor(ss, 4);
            const float rstd = rsqrtf(ss * (1.f / 64.f) + EPS);
            const float* gp = (grp >> 3) ? P.in[I_KN] + l * 64 + 8 * c : P.in[I_QN] + l * 64 + 8 * c;
            float y[8];
#pragma unroll
            for (int e = 0; e < 8; ++e) y[e] = f[e] * rstd * gp[e];
            if (!ctx) { const int pos = (c < 4) ? (t >> 6) : (t & 63); const float* tp = tab + (pos * 16 + (c & 1) * 8) * 2; const bool first = (c & 2) == 0;
#pragma unroll
                for (int e = 0; e < 8; ++e) { const float pr = __shfl_xor(y[e], 2); const float cs = tp[2 * e], sn = tp[2 * e + 1];
                    y[e] = first ? (y[e] * cs - pr * sn) : (pr * sn + y[e] * cs); } }
            if (grp < 8) {
#pragma unroll
                for (int e = 0; e < 8; ++e) y[e] *= 0.18033688011112042f;
                *(u32x4*)(Q + (size_t)m * 512 + grp * 64 + 8 * c) = pack8(y);
            } else { const int g2 = grp - 8, h = g2 >> 1, half = g2 & 1;
                bf16* kd = ctx ? (bf16*)(P.ws + WS_KCTX) + ((size_t)(b * 4 + h) * 256 + t) * 128 + half * 64 + 8 * c : (bf16*)(P.ws + WS_KSMP) + ((size_t)(b * 4 + h) * 1280 + 256 + t) * 128 + half * 64 + 8 * c;
                *(u32x4*)kd = pack8(y);
                if (ctx) { float* ok = P.out + O_CK + ((size_t)(b * 2 + l) * 256 + t) * 512 + g2 * 64 + 8 * c; *(f32x4*)ok = (f32x4){y[0], y[1], y[2], y[3]}; *(f32x4*)(ok + 4) = (f32x4){y[4], y[5], y[6], y[7]}; } }
        }
    }
    ldsp VL = lds;
    u32x4 vraws[8];
#pragma unroll
    for (int i = 0; i < 8; ++i) { const int id = tid + 512 * i, tok = id >> 6, cc = id & 63; vraws[i] = *(const u32x4*)(Z + (size_t)(m0 + tok) * INW + 2560 + 8 * cc); }
#pragma unroll
    for (int i = 0; i < 8; ++i) { const int id = tid + 512 * i, tok = id >> 6, cc = id & 63;
        const u32x4 raw = vraws[i];
        *(LAS u32x4*)(VL + tok * 1040 + 16 * (cc ^ ((tok >> 3) & 7))) = raw;
        if (ctx) { float f[8]; unpack8(raw, f); float* ov = P.out + O_CV + ((size_t)(b * 2 + l) * 256 + t0 + tok) * 512 + 8 * cc; *(f32x4*)ov = (f32x4){f[0], f[1], f[2], f[3]}; *(f32x4*)(ov + 4) = (f32x4){f[4], f[5], f[6], f[7]}; } }
    __syncthreads();
#pragma unroll 2
    for (int i = 0; i < 8; ++i) { const int id = tid + 512 * i, kc = id & 7, col = id >> 3;
        unsigned short v[8];
#pragma unroll
        for (int e = 0; e < 8; ++e) v[e] = *(const LAS bf16*)(VL + (8 * kc + e) * 1040 + 16 * ((col >> 3) ^ kc) + (col & 7) * 2);
        u32x4 o; o.x = v[0] | ((unsigned)v[1] << 16); o.y = v[2] | ((unsigned)v[3] << 16); o.z = v[4] | ((unsigned)v[5] << 16); o.w = v[6] | ((unsigned)v[7] << 16);
        bf16* vd = ctx ? (bf16*)(P.ws + WS_VTCTX) + ((size_t)b * 512 + col) * 256 + t0 + 8 * kc : (bf16*)(P.ws + WS_VTSMP) + ((size_t)b * 512 + col) * 1280 + 256 + t0 + 8 * kc;
        *(u32x4*)vd = o; }
}
DI void attn_unit(const Params& P, int l, int au, ldsp lds, float lam, float osc) {
    const int tid = opaque_tid(), lane = tid & 63, wid = tid >> 6, r32 = lane & 31, hh = lane >> 5, rg = wid & 3, kg = wid >> 2;
    int b, h, qrow0, np, ldvt; const bf16 *Kb, *VTb;
    if (au < 256) { b = au >> 5; h = (au >> 3) & 3; const int qb = au & 7; qrow0 = NCTX + b * 1024 + qb * 128; np = 10; ldvt = 1280;
        Kb = (const bf16*)(P.ws + WS_KSMP) + ((size_t)(b * 4 + h) * 1280) * 128; VTb = (const bf16*)(P.ws + WS_VTSMP) + ((size_t)(b * 4 + h) * 128) * 1280; }
    else { const int a2 = au - 256; b = a2 >> 3; h = (a2 >> 1) & 3; qrow0 = b * 256 + 128 * (a2 & 1); np = 2; ldvt = 256;
        Kb = (const bf16*)(P.ws + WS_KCTX) + ((size_t)(b * 4 + h) * 256) * 128; VTb = (const bf16*)(P.ws + WS_VTCTX) + ((size_t)(b * 4 + h) * 128) * 256; }
    ldsp KL = lds + kg * 17408; ldsp VL = lds + 34816 + kg * 18432;
    ldsp ST = lds + 73728;
    const bf16* qp = (const bf16*)(P.ws + WS_Q) + (size_t)(qrow0 + 32 * rg + r32) * 512 + h * 128;
    bf16x8 qf[2][4];
#pragma unroll
    for (int i = 0; i < 2; ++i)
#pragma unroll
        for (int s = 0; s < 4; ++s) qf[i][s] = *(const bf16x8*)(qp + i * 64 + 16 * s + 8 * hh);
    u32x4 kreg[4], vreg[4];
    float mm[2] = {-INFINITY, -INFINITY}, ll[2] = {0.f, 0.f};
#define LOADK(tp) do { _Pragma("unroll") for (int _i = 0; _i < 4; ++_i) { const int _id = tid + 512 * _i; kreg[_i] = *(const u32x4*)(Kb + (size_t)(128 * (tp) + (_id >> 4)) * 128 + 8 * (_id & 15)); } } while (0)
#define LOADV(tp) do { _Pragma("unroll") for (int _i = 0; _i < 4; ++_i) { const int _id = tid + 512 * _i; vreg[_i] = *(const u32x4*)(VTb + (size_t)((_id >> 3) & 127) * ldvt + 128 * (tp) + 64 * (_id >> 10) + 8 * (_id & 7)); } } while (0)
#define STOREK() do { _Pragma("unroll") for (int _i = 0; _i < 4; ++_i) { const int _id = tid + 512 * _i; *(LAS u32x4*)(lds + (_id >> 10) * 17408 + ((_id >> 4) & 63) * 272 + 16 * (_id & 15)) = kreg[_i]; } } while (0)
#define STOREV() do { _Pragma("unroll") for (int _i = 0; _i < 4; ++_i) { const int _id = tid + 512 * _i; *(LAS u32x4*)(lds + 34816 + (_id >> 10) * 18432 + ((_id >> 3) & 127) * 144 + 16 * (_id & 7)) = vreg[_i]; } } while (0)
    LOADK(0);
    for (int tp = 0; tp < np; ++tp) {
        __syncthreads(); STOREK(); __syncthreads();
        if (tp + 1 < np) LOADK(tp + 1);
#pragma unroll
        for (int i = 0; i < 2; ++i) {
            f32x16 s0, s1;
#pragma unroll
            for (int r = 0; r < 16; ++r) { s0[r] = 0.f; s1[r] = 0.f; }
#pragma unroll
            for (int s = 0; s < 4; ++s) { const bf16x8 k0 = *(const LAS bf16x8*)(KL + r32 * 272 + (64 * i + 16 * s + 8 * hh) * 2), k1 = *(const LAS bf16x8*)(KL + (32 + r32) * 272 + (64 * i + 16 * s + 8 * hh) * 2);
                s0 = MFMA32(k0, qf[i][s], s0); s1 = MFMA32(k1, qf[i][s], s1); }
            float mx = s0[0];
#pragma unroll
            for (int r = 0; r < 16; ++r) mx = fmaxf(mx, fmaxf(s0[r], s1[r]));
            mx = fmaxf(mx, __shfl_xor(mx, 32));
            const float mn = fmaxf(mm[i], mx); float sum = 0.f;
#pragma unroll
            for (int r = 0; r < 16; ++r) sum += ex2(s0[r] - mn) + ex2(s1[r] - mn);
            ll[i] = ll[i] * ex2(mm[i] - mn) + sum; mm[i] = mn;
        }
    }
    ll[0] += __shfl_xor(ll[0], 32); ll[1] += __shfl_xor(ll[1], 32);
    if (hh == 0) {
#pragma unroll
        for (int i = 0; i < 2; ++i) *(LAS f32x2_t*)(ST + (((kg * 4 + rg) * 2 + i) * 32 + r32) * 8) = (f32x2_t){mm[i], ll[i]};
    }
    LOADK(0); LOADV(0);
    __syncthreads();
    float nb[2];
#pragma unroll
    for (int i = 0; i < 2; ++i) { const f32x2_t o2 = *(const LAS f32x2_t*)(ST + ((((1 - kg) * 4 + rg) * 2 + i) * 32 + r32) * 8);
        const float M = fmaxf(mm[i], o2[0]); const float L = ll[i] * ex2(mm[i] - M) + o2[1] * ex2(o2[0] - M); nb[i] = -(M + __builtin_amdgcn_logf(L)); }
    nb[1] += __builtin_amdgcn_logf(fabsf(lam));
    const float lsgn = lam < 0.f ? -1.f : 1.f;
    f32x16 o[4];
#pragma unroll
    for (int d = 0; d < 4; ++d)
#pragma unroll
        for (int r = 0; r < 16; ++r) o[d][r] = 0.f;
    for (int tp = 0; tp < np; ++tp) {
        __syncthreads(); STOREK(); STOREV(); __syncthreads();
        if (tp + 1 < np) { LOADK(tp + 1); LOADV(tp + 1); }
#pragma unroll
        for (int kb = 0; kb < 2; ++kb) {
            f32x16 pa, s1;
#pragma unroll
            for (int r = 0; r < 16; ++r) { pa[r] = nb[0]; s1[r] = nb[1]; }
#pragma unroll
            for (int s = 0; s < 4; ++s) { const bf16x8 kf = *(const LAS bf16x8*)(KL + (32 * kb + r32) * 272 + (16 * s + 8 * hh) * 2); pa = MFMA32(kf, qf[0][s], pa); }
#pragma unroll
            for (int s = 0; s < 4; ++s) { const bf16x8 kf = *(const LAS bf16x8*)(KL + (32 * kb + r32) * 272 + (64 + 16 * s + 8 * hh) * 2); s1 = MFMA32(kf, qf[1][s], s1); }
#pragma unroll
            for (int r = 0; r < 16; ++r) pa[r] = ex2(pa[r]) - lsgn * ex2(s1[r]);
#pragma unroll
            for (int sp = 0; sp < 2; ++sp) { const int ks = 2 * kb + sp;
                u32x4 pw; pw.x = pk2(pa[8 * sp + 0], pa[8 * sp + 1]); pw.y = pk2(pa[8 * sp + 2], pa[8 * sp + 3]); pw.z = pk2(pa[8 * sp + 4], pa[8 * sp + 5]); pw.w = pk2(pa[8 * sp + 6], pa[8 * sp + 7]);
                const bf16x8 pb = __builtin_bit_cast(bf16x8, pw);
#pragma unroll
                for (int d = 0; d < 4; ++d) { const s16x4 lo = *(const LAS s16x4*)(VL + (32 * d + r32) * 144 + (16 * ks + 4 * hh) * 2), hi = *(const LAS s16x4*)(VL + (32 * d + r32) * 144 + (16 * ks + 8 + 4 * hh) * 2);
                    const bf16x8 va = __builtin_shufflevector(lo, hi, 0, 1, 2, 3, 4, 5, 6, 7); o[d] = MFMA32(va, pb, o[d]); }
            }
        }
    }
#undef LOADK
#undef LOADV
#undef STOREK
#undef STOREV
    __syncthreads();
    ldsp OX = lds + (32 * rg + r32) * 528;
    if (kg == 1) {
#pragma unroll
        for (int d = 0; d < 4; ++d)
#pragma unroll
            for (int g4 = 0; g4 < 4; ++g4) *(LAS f32x4*)(OX + (32 * d + 8 * g4 + 4 * hh) * 4) = (f32x4){o[d][4 * g4 + 0], o[d][4 * g4 + 1], o[d][4 * g4 + 2], o[d][4 * g4 + 3]};
    }
    __syncthreads();
    if (kg == 0) {
        float ss = 0.f;
#pragma unroll
        for (int d = 0; d < 4; ++d)
#pragma unroll
            for (int g4 = 0; g4 < 4; ++g4) { const f32x4 t = *(const LAS f32x4*)(OX + (32 * d + 8 * g4 + 4 * hh) * 4);
#pragma unroll
                for (int e = 0; e < 4; ++e) { o[d][4 * g4 + e] += t[e]; ss += o[d][4 * g4 + e] * o[d][4 * g4 + e]; } }
        ss += __shfl_xor(ss, 32);
        const float rstd = rsqrtf(ss * (1.f / 128.f) + EPS) * osc;
        const float* dn = P.in[I_DN] + l * 128;
        bf16* dst = (bf16*)(P.ws + WS_H) + (size_t)(qrow0 + 32 * rg + r32) * DM + 512 + h * 128;
#pragma unroll
        for (int d = 0; d < 4; ++d)
#pragma unroll
            for (int g4 = 0; g4 < 4; ++g4) { const int d0 = 32 * d + 8 * g4 + 4 * hh; const f32x4 w = *(const f32x4*)(dn + d0);
                u32x2 ov; ov.x = pk2(o[d][4 * g4 + 0] * rstd * w[0], o[d][4 * g4 + 1] * rstd * w[1]); ov.y = pk2(o[d][4 * g4 + 2] * rstd * w[2], o[d][4 * g4 + 3] * rstd * w[3]);
                *(u32x2*)(dst + d0) = ov; }
    }
}
DI void unpack8v(const u32x4 r, f32x2_t (&f)[4]) { f[0] = (f32x2_t){bflo(r.x), bfhi(r.x)}; f[1] = (f32x2_t){bflo(r.y), bfhi(r.y)}; f[2] = (f32x2_t){bflo(r.z), bfhi(r.z)}; f[3] = (f32x2_t){bflo(r.w), bfhi(r.w)}; }
DI void phase_convgate(const Params& P, int l, int hf) {
    const bf16* __restrict__ UP = (const bf16*)(P.ws + WS_UP); bf16* __restrict__ Gb = (bf16*)(P.ws + WS_G) + (size_t)hf * 8192 * DFF;
    const int seqlen = hf ? 1024 : 256;
    const float* __restrict__ cw = P.in[I_FCONV] + (size_t)l * 3 * UPW; const float* __restrict__ cb = P.in[I_FCB] + (size_t)l * UPW;
    const int nitems = 1024 * 352;
    for (int it = blockIdx.x * 512 + opaque_tid(); it < nitems; it += gridDim.x * 512) {
        const int strip = it / 352, ch = it % 352, n0 = 8 * ch, r0 = strip * 8, t0 = r0 % seqlen;
        u32x4 ra[10], rb[10];
        const bool has_prev = t0 != 0, has_next = (t0 + 8) != seqlen;
#pragma unroll
        for (int i = 0; i < 10; ++i) { const int r = r0 - 1 + i; const bool ok = (i == 0) ? has_prev : ((i == 9) ? has_next : true);
            if (ok) { ra[i] = *(const u32x4*)(UP + (size_t)r * UPW + n0); rb[i] = *(const u32x4*)(UP + (size_t)r * UPW + DFF + n0); }
            else { ra[i] = (u32x4){0u, 0u, 0u, 0u}; rb[i] = ra[i]; } }
        f32x2_t wa[3][4], wb[3][4], ba[4], bb[4];
#pragma unroll
        for (int j = 0; j < 3; ++j)
#pragma unroll
            for (int q = 0; q < 4; ++q) { wa[j][q] = *(const f32x2_t*)(cw + j * UPW + n0 + 2 * q); wb[j][q] = *(const f32x2_t*)(cw + j * UPW + DFF + n0 + 2 * q); }
#pragma unroll
        for (int q = 0; q < 4; ++q) { ba[q] = *(const f32x2_t*)(cb + n0 + 2 * q); bb[q] = *(const f32x2_t*)(cb + DFF + n0 + 2 * q); }
        f32x2_t pa[4], pb[4], ca[4], cbv[4], na[4], nb[4];
        unpack8v(ra[0], pa); unpack8v(rb[0], pb); unpack8v(ra[1], ca); unpack8v(rb[1], cbv);
#pragma unroll
        for (int rr = 0; rr < 8; ++rr) { const int r = r0 + rr;
            unpack8v(ra[rr + 2], na); unpack8v(rb[rr + 2], nb);
            u32x4 o; unsigned ow[4];
#pragma unroll
            for (int q = 0; q < 4; ++q) { const f32x2_t ya = wa[0][q] * pa[q] + wa[1][q] * ca[q] + wa[2][q] * na[q] + ba[q], yb = wb[0][q] * pb[q] + wb[1][q] * cbv[q] + wb[2][q] * nb[q] + bb[q];
                const f32x2_t tt = ya * -1.4426950409f; f32x2_t e; e.x = ex2(tt.x); e.y = ex2(tt.y); e = e + 1.f;
                f32x2_t rc; rc.x = __builtin_amdgcn_rcpf(e.x); rc.y = __builtin_amdgcn_rcpf(e.y);
                const f32x2_t g = (ya * rc) * yb; ow[q] = pk2(g.x, g.y);
                pa[q] = ca[q]; pb[q] = cbv[q]; ca[q] = na[q]; cbv[q] = nb[q]; }
            o.x = ow[0]; o.y = ow[1]; o.z = ow[2]; o.w = ow[3];
            *(u32x4*)(Gb + (size_t)r * DFF + n0) = o; }
    }
}

#define XB_TMO      128
#define XB_XCNT(j)  (256  + 64 * (j))
#define XB_XSUB(j)  (1280 + 64 * (j))
#define XB_XGEN(j)  (2304 + 64 * (j))
#define XB_TOP      3328
#define XB_TOPGEN   3392
#define XCD_BAR_WORDS 3456
#define XB_SPIN_CAP (1u << 18)

__device__ __forceinline__ unsigned xb_ld(unsigned* p)              { return __hip_atomic_load(p, __ATOMIC_RELAXED, __HIP_MEMORY_SCOPE_AGENT); }
__device__ __forceinline__ unsigned xb_add(unsigned* p, unsigned v) { return __hip_atomic_fetch_add(p, v, __ATOMIC_RELAXED, __HIP_MEMORY_SCOPE_AGENT); }
__device__ __forceinline__ unsigned xb_xcc_id() { return (unsigned)__builtin_amdgcn_s_getreg((3 << 11) | 20) & 0xFu; }
#define XB_SPIN(cond, bar) do { unsigned _sp = 0; while (cond) { __builtin_amdgcn_s_sleep(1); \
    if ((++_sp & 255u) == 0u) { if (xb_ld(&(bar)[XB_TMO])) break; if (_sp > XB_SPIN_CAP) { atomicAdd(&(bar)[XB_TMO], 1u); break; } } } } while (0)

struct XcdBarrier {
    unsigned* bar; unsigned x;
    volatile LAS unsigned* st;
};

__device__ __forceinline__ XcdBarrier xcd_barrier_post(unsigned* bar, volatile LAS unsigned* st) {
    XcdBarrier b; b.bar = bar; b.x = xb_xcc_id(); b.st = st;
    if (threadIdx.x == 0) (void)xb_add(&bar[XB_XCNT(b.x)], 1u);
    return b;
}
__device__ __forceinline__ void xcd_barrier_complete(unsigned* bar, unsigned x, unsigned& nloc, unsigned& nx) {
    const unsigned G = gridDim.x * gridDim.y * gridDim.z;
    unsigned sum, cnt, mine, sp = 0u;
    for (;;) {
        sum = 0u; cnt = 0u; mine = 0u;
#pragma unroll
        for (unsigned j = 0; j < 16; ++j) { const unsigned c = xb_ld(&bar[XB_XCNT(j)]); sum += c; cnt += (c > 0u) ? 1u : 0u; mine = (j == x) ? c : mine; }
        if (sum == G) break;
        __builtin_amdgcn_s_sleep(1);
        if ((++sp & 255u) == 0u) { if (xb_ld(&bar[XB_TMO])) break; if (sp > XB_SPIN_CAP) { atomicAdd(&bar[XB_TMO], 1u); break; } }
    }
    nloc = mine > 0u ? mine : 1u; nx = cnt > 0u ? cnt : 1u;
}

__device__ __forceinline__ void xcd_barrier(const XcdBarrier& b) {
    asm volatile("s_waitcnt vmcnt(0)" ::: "memory");
    __syncthreads();
    if (threadIdx.x == 0) {
        unsigned* bar = b.bar;
        __builtin_amdgcn_s_waitcnt(0);
        unsigned nloc = b.st[0], nx = b.st[1];
        if (nloc == 0u) { xcd_barrier_complete(bar, b.x, nloc, nx); b.st[0] = nloc; b.st[1] = nx; }
        const unsigned old = xb_add(&bar[XB_XSUB(b.x)], 1u);
        const unsigned gen = old / nloc;
        if (old + 1u == (gen + 1u) * nloc) {
            __builtin_amdgcn_fence(__ATOMIC_RELEASE, "agent");
            asm volatile("s_waitcnt vmcnt(0)" ::: "memory");
            const unsigned og = xb_add(&bar[XB_TOP], 1u);
            const unsigned tg = og / nx;
            if (og + 1u == (tg + 1u) * nx) xb_add(&bar[XB_TOPGEN], 1u);
            else XB_SPIN(xb_ld(&bar[XB_TOPGEN]) == tg, bar);
            __builtin_amdgcn_fence(__ATOMIC_ACQUIRE, "agent");
            xb_add(&bar[XB_XGEN(b.x)], 1u);
            asm volatile("s_waitcnt vmcnt(0)" ::: "memory");
        } else {
            XB_SPIN(xb_ld(&bar[XB_XGEN(b.x)]) == gen, bar);
            __builtin_amdgcn_fence(__ATOMIC_ACQUIRE, "agent");
            asm volatile("s_waitcnt vmcnt(0)" ::: "memory");
        }
    }
    __syncthreads();
}

constexpr size_t WS_BAR = 16 * 1024;
#ifndef EN_G1
#define EN_G1 1
#endif
#ifndef EN_G2
#define EN_G2 1
#endif
#ifndef EN_MA
#define EN_MA 1
#endif
#ifndef EN_MB
#define EN_MB 1
#endif
#ifndef EN_AT
#define EN_AT 1
#endif
#ifndef EN_RO
#define EN_RO 1
#endif
#ifndef EN_CG
#define EN_CG 1
#endif
#ifndef DUP_MASK
#define DUP_MASK 0
#endif
#ifndef DUP_SKIP
#define DUP_SKIP 0
#endif
#define REPS(k) (((DUP_MASK >> (k)) & 1) ? 2 : 1)
#define REPLOOP(k) _Pragma("unroll") for (int rep = 0; rep < REPS(k); ++rep)
#define REPSYNC(k) do { if (rep + 1 < REPS(k)) xcd_barrier(xbar); } while (0)
#define IN(k) (lo <= (k) && (k) < hi)
#ifndef SYNC_REPS
#define SYNC_REPS 1
#endif
#define SEAM(k) do { if (IN(k) && IN((k) + 1)) { for (int _s = 0; _s < SYNC_REPS; ++_s) xcd_barrier(xbar); } } while (0)
template <int L> DI void layer_phases(const Params& P, ldsp lds, const int lo, const int hi, const XcdBarrier& xbar) {
    constexpr int B = 1 + 11 * L;
    const int G = gridDim.x;
    const float* mods_l = (const float*)(P.ws + WS_MODS) + (size_t)L * 9 * 6144;
    const bf16* win_t = (const bf16*)(P.ws + (L ? WS_WIN1 : WS_WIN)); const bf16* wout_t = (const bf16*)(P.ws + (L ? WS_WOUT1 : WS_WOUT)); const bf16* wup_t = (const bf16*)(P.ws + (L ? WS_WUP1 : WS_WUP));
    float* SS2 = (float*)(P.ws + WS_SS) + (L == 0 ? 0 : 2) * 16384; float* SS1 = (float*)(P.ws + WS_SS) + 16384; const float* shw = (const float*)(P.ws + WS_SHW);
    if (L == 0) {
        if (IN(B + 0)) REPLOOP(12) { phase_norm(P, P.in[I_XP], P.in[I_XS], P.in[I_N1], mods_l, 0, 1024); __syncthreads(); phase_shw(P, lds); REPSYNC(12); }
        SEAM(B + 0);
    }
    if (EN_G1 && IN(B + 1)) REPLOOP(1) {
        pg8::Gemm g{(const bf16*)(P.ws + WS_H), win_t, MTOK, INW, DM};
        pg8::StaticOrder S; S.init(MTOK, INW, G, (int)blockIdx.x);
        if (L == 0) { pg8::EpiBf16<0> E{(bf16*)(P.ws + WS_Z), INW, nullptr, 0, 0, 1.f}; pg8::gemm_phase<pg8::EpiBf16<0>, pg8::StaticOrder, true, true>(lds, g, S, E); }
        else { EpiBf16Fold E{(bf16*)(P.ws + WS_Z), INW, SS1, shw + SHW_SET, INW, 0}; pg8::gemm_phase<EpiBf16Fold, pg8::StaticOrder, true, true>(lds, g, S, E); }
        REPSYNC(1);
    }
    SEAM(B + 1);
    if (EN_MA && IN(B + 2)) REPLOOP(2) {
        if (L > 0) phase_prep(P, L, lds, 2 | 4);
        __syncthreads();
        for (int vb = blockIdx.x; vb < 256; vb += G) {
            sgu_unit(P, L, vb >> 1, lds, vb & 1); __syncthreads();
            cprep_unit(P, L, vb, lds); __syncthreads();
            rets_unit(P, L, 2 * vb, lds); __syncthreads(); rets_unit(P, L, 2 * vb + 1, lds); __syncthreads();
        }
        REPSYNC(2);
    }
    SEAM(B + 2);
    if (EN_MB && IN(B + 3)) REPLOOP(3) {
        unsigned* ctr = (unsigned*)(P.ws + WS_CTR) + (B + 3) + 32 * rep;
        const float* dl = P.in[I_DLAM] + L * 256; const int lane = opaque_tid() & 63;
        const float s1 = wave_sum(dl[lane] * dl[64 + lane]), s2 = wave_sum(dl[128 + lane] * dl[192 + lane]);
        const float lam_init = L == 0 ? 0.2f : 0.35550906759f;
        const float lam = expf(s1) - expf(s2) + lam_init;
        if (EN_AT && !(rep == 1 && (DUP_SKIP & 1))) {
#pragma unroll 1
            for (int pass = 0; pass < 2; ++pass)
#pragma unroll 1
                for (int vb = blockIdx.x; vb < 256; vb += G) { const int x = vb & 7, sl = vb >> 3;
                    const int u = pass == 0 ? (4 * x + (sl >> 3)) * 8 + (sl & 7) : 256 + (16 * x + (sl >> 1)) * 2 + (sl & 1);
                    __syncthreads(); attn_unit(P, L, u, lds, lam, 1.f - lam_init); }
        }
        if (EN_RO && !(rep == 1 && (DUP_SKIP & 2))) for (int u = blockIdx.x; u < 512; u += G) { __syncthreads(); reto_unit(P, L, u, lds); }
        REPSYNC(3);
    }
    SEAM(B + 3);
    if (EN_G2 && IN(B + 4)) {
        pg8::Gemm g{(const bf16*)(P.ws + WS_H), wout_t, MTOK, DM, DM};
        EpiResidFold<L == 0 ? 1 : 0> E{L == 0 ? P.in[I_XP] : P.out, L == 0 ? P.in[I_XS] : P.out + (size_t)NCTX * DM, P.out, mods_l + 2048, P.in[I_N2] + L * DM, mods_l + 4096, (bf16*)(P.ws + WS_H2), SS2};
        pg8::StaticOrder S; S.init(MTOK, DM, G, (int)blockIdx.x);
        pg8::gemm_phase<EpiResidFold<L == 0 ? 1 : 0>, pg8::StaticOrder, true, true>(lds, g, S, E);
    }
    SEAM(B + 4);
#pragma unroll
    for (int hf = 0; hf < 2; ++hf) {
        if (EN_G1 && IN(B + 6 + 2 * hf)) REPLOOP(6) {
            pg8::Gemm g{(const bf16*)(P.ws + WS_H2) + (size_t)hf * 8192 * DM, wup_t, 8192, UPW, DM};
            EpiBf16Fold E{(bf16*)(P.ws + WS_UP), UPW, SS2, shw + (L == 0 ? 0 : 2 * SHW_SET), UPW, 32 * hf};
            pg8::StaticOrder S; S.init(8192, UPW, G, (int)blockIdx.x);
            pg8::gemm_phase<EpiBf16Fold, pg8::StaticOrder, true, true>(lds, g, S, E);
            if (L == 0 && rep == 0 && G == 256 && blockIdx.x >= 192) { __syncthreads(); phase_prep(P, 1, lds, 1, 192, 64, hf); }
            REPSYNC(6);
        }
        SEAM(B + 6 + 2 * hf);
        if (EN_CG && IN(B + 7 + 2 * hf)) REPLOOP(7) { phase_convgate(P, L, hf); REPSYNC(7); }
        SEAM(B + 7 + 2 * hf);
    }
    if (EN_G2 && IN(B + 10)) {
        pg8::Gemm g{(const bf16*)(P.ws + WS_G), (const bf16*)(P.ws + WS_WDN), MTOK, DM, DFF};
        pg8::StaticOrder S; S.init(MTOK, DM, G, (int)blockIdx.x);
        if (L == 0) {
            const float* mods_n = (const float*)(P.ws + WS_MODS) + (size_t)9 * 6144;
            EpiResidFold<2> E{P.out, P.out + (size_t)NCTX * DM, P.out, mods_l + 5120, P.in[I_N1] + DM, mods_n + 1024, (bf16*)(P.ws + WS_H), SS1};
            pg8::gemm_phase<EpiResidFold<2>, pg8::StaticOrder, true, true>(lds, g, S, E);
        } else { EpiResid E{P.out, P.out + (size_t)NCTX * DM, P.out, mods_l + 5120}; pg8::gemm_phase<EpiResid, pg8::StaticOrder, true, true>(lds, g, S, E); }
    }
    if (L == 0) SEAM(B + 10);
}
__global__ void __launch_bounds__(512, 2) mk_fwd(Params P) {
    extern __shared__ __attribute__((aligned(16))) unsigned char lds_raw[];
    ldsp lds = (ldsp)lds_raw;
    cg::grid_group grid = cg::this_grid();
    const int lo = P.ph_lo, hi = P.ph_hi;
    if (threadIdx.x < 8) ((LAS unsigned*)(lds + LDS_MAIN))[threadIdx.x] = 0u;
    __syncthreads();
    unsigned* barw = (unsigned*)(P.ws + WS_BAR);
    if (P.coop == 2) grid.sync();
    XcdBarrier xbar; xbar.bar = barw; xbar.x = 0; xbar.st = nullptr;
    if (hi - lo > 1) xbar = xcd_barrier_post(barw, (volatile LAS unsigned*)(lds + LDS_MAIN + 16));
    if (IN(0)) REPLOOP(11) { phase_tables(P); phase_mods(P, lds); __syncthreads(); phase_prep(P, 0, lds, 1 | 2 | 4); if (gridDim.x != 256) phase_prep(P, 1, lds, 1); REPSYNC(11); }
    SEAM(0);
    layer_phases<0>(P, lds, lo, hi, xbar);
    layer_phases<1>(P, lds, lo, hi, xbar);
}
#undef IN
#undef SEAM

extern "C" void kernel_launch(void* const* d_in, const int* in_sizes, int n_in, void* d_out, int out_size, void* d_ws, size_t ws_size, hipStream_t stream) {
    static int grid = 0;
    if (grid == 0) {
        if (n_in != N_IN || (size_t)out_size != O_END || ws_size < WS_END) { fprintf(stderr, "kernel_launch: unexpected sizes n_in %d out %d ws %zu\n", n_in, out_size, ws_size); grid = -1; return; }
        int dev = 0, cus = 0, per_cu = 0;
        if (hipGetDevice(&dev) != hipSuccess || hipDeviceGetAttribute(&cus, hipDeviceAttributeMultiprocessorCount, dev) != hipSuccess) { grid = -1; return; }
        if (hipFuncSetAttribute((const void*)mk_fwd, hipFuncAttributeMaxDynamicSharedMemorySize, LDS_BYTES) != hipSuccess) { fprintf(stderr, "kernel_launch: hipFuncSetAttribute failed\n"); grid = -1; return; }
        if (hipOccupancyMaxActiveBlocksPerMultiprocessor(&per_cu, (const void*)mk_fwd, 512, LDS_BYTES) != hipSuccess || per_cu < 1) { per_cu = 1; (void)hipGetLastError(); }
        grid = cus * 1;
    }
    if (grid < 0) return;
    if (hipMemsetAsync(d_ws, 0, WS_ZERO_BYTES, stream) != hipSuccess) { fprintf(stderr, "kernel_launch: memset failed\n"); return; }
    Params p{};
    for (int i = 0; i < N_IN; ++i) p.in[i] = (const float*)d_in[i];
    p.out = (float*)d_out; p.ws = (unsigned char*)d_ws; p.coop = KL_COOP; p.pad = 0;
#if KL_COOP
    p.ph_lo = 0; p.ph_hi = NPH;
    void* args[] = {&p};
    hipError_t e = hipLaunchCooperativeKernel((const void*)mk_fwd, dim3(grid), dim3(512), args, LDS_BYTES, stream);
    if (e != hipSuccess) fprintf(stderr, "cooperative launch failed: %s (grid %d)\n", hipGetErrorString(e), grid);
#else
    for (int ph = 0; ph < NPH; ++ph) { p.ph_lo = ph; p.ph_hi = ph + 1; hipLaunchKernelGGL(mk_fwd, dim3(grid), dim3(512), LDS_BYTES, stream, p); }
#endif
}
```

```cpp
#include <hip/hip_runtime.h>
#include <hip/hip_cooperative_groups.h>
#include <cstdio>
#include <cstdint>
namespace cg = cooperative_groups;
#ifndef KL_COOP
#define KL_COOP 1
#endif
namespace pg8 {
#define PG8_LAS __attribute__((address_space(3)))
typedef unsigned short bf16_t;
typedef short bf16x8 __attribute__((ext_vector_type(8)));
typedef float f32x4 __attribute__((ext_vector_type(4)));
typedef unsigned u32x4 __attribute__((ext_vector_type(4)));
constexpr int BM = 256, BK = 64, HALF = 128, HTB = HALF * BK * 2  , STAGE_BYTES = 8 * HTB, NXCD = 8, WGM = 8;

__host__ __device__ __forceinline__ int lds_byte(int r, int c) { const int st = (r >> 4) * 2 + (c >> 5), rr = r & 15, cc = c & 31, ob = rr * 64 + cc * 2; return st * 1024 + (ob ^ (((ob >> 9) & 1) << 5)); }
__host__ __device__ __forceinline__ void stage_rc(int b, int& R, int& C) { const int st = b / 1024, sb = b % 1024, swz = sb ^ (((sb >> 9) & 1) << 5); R = (st >> 1) * 16 + swz / 64; C = (st & 1) * 32 + (swz % 64) / 2; }
__host__ __device__ __forceinline__ int perm32(int rho) { const int n = rho >> 4, i = rho & 15; return 8 * (i >> 2) + 4 * n + (i & 3); }

struct Unit { int pm, pn; };
struct Gemm { const bf16_t* A; const bf16_t* Bt; int M, N, K; };

struct StaticOrder {
    int nM, nN, nwg, G, c;
    __host__ __device__ void init(int M, int N, int G_, int c_) { nM = M / BM; nN = N / BM; nwg = nM * nN; G = G_; c = c_; }
    __host__ __device__ bool next(int i, Unit& u) const {
        const long L = (long)i * G + c; if (L >= nwg) return false;
        int wgid = (int)L; { const int q = nwg / NXCD, r = nwg % NXCD, xcd = wgid % NXCD, off = wgid / NXCD; wgid = (xcd < r ? xcd * (q + 1) : r * (q + 1) + (xcd - r) * q) + off; }
        const int nig = WGM * nN, gid = wgid / nig, fm = gid * WGM, gsz = (nM - fm) < WGM ? (nM - fm) : WGM;
        u.pm = fm + ((wgid % nig) % gsz); u.pn = (wgid % nig) / gsz; return true;
    }
    __device__ __forceinline__ void a_ready(const Unit&) const {}
    __device__ __forceinline__ void done(const Unit&) const {}
};

__device__ __forceinline__ unsigned cvt_pk_bf16(float lo, float hi) { unsigned r; asm volatile("v_cvt_pk_bf16_f32 %0, %1, %2" : "=v"(r) : "v"(lo), "v"(hi)); return r; }
typedef float f32x2 __attribute__((ext_vector_type(2)));
__device__ __forceinline__ f32x2 gelu_pk(f32x2 v) {
    const f32x2 av = __builtin_elementwise_abs(v), d = av * 0.2316418882f + 1.0f;
    f32x2 t; t.x = __builtin_amdgcn_rcpf(d.x); t.y = __builtin_amdgcn_rcpf(d.y);
    f32x2 q = t * 0.5307027145f + (-0.7265760135f); q = q * t + 0.7107068705f; q = q * t + (-0.142248368f); q = q * t + 0.127414796f; q = q * t;
    const f32x2 s = (v * v) * (-0.72134752044f);
    f32x2 e; e.x = __builtin_amdgcn_exp2f(s.x); e.y = __builtin_amdgcn_exp2f(s.y);
    const f32x2 m = v * (q * e), r = v - m;
    f32x2 o; o.x = v.x < 0.f ? m.x : r.x; o.y = v.y < 0.f ? m.y : r.y; return o;
}

template <int ACT  > struct EpiBf16 {
    static constexpr bool PERM = true, AFTER_DRAIN = false; static_assert(ACT == 0 || ACT == 1, "EpiBf16: ACT is 0 (none) or 1 (gelu_pk)");
    bf16_t* O; int ldc; const float* bias; int split_cols; size_t split_stride; float scale0;
    __device__ __forceinline__ void operator()(const f32x4 (&acc)[2][2][4][2], const Unit& u, int wr, int wc, int fr, int fq) const {
        const int row0 = u.pm * BM + wr * 64 + fr; int colt = u.pn * BM; bf16_t* base = O;
        float sc = 1.f; if (split_cols) { const int t = colt / split_cols; base += (size_t)t * split_stride; colt -= t * split_cols; if (t == 0) sc = scale0; }
        const int col0 = colt + wc * 32 + 8 * fq, bcol0 = u.pn * BM + wc * 32 + 8 * fq;
        f32x4 bv[2][2];
#pragma unroll
        for (int bj = 0; bj < 2; ++bj)
#pragma unroll
            for (int n = 0; n < 2; ++n) bv[bj][n] = bias ? *(const f32x4*)(bias + bcol0 + bj * HALF + 4 * n) : (f32x4){0.f, 0.f, 0.f, 0.f};
#pragma unroll
        for (int ai = 0; ai < 2; ++ai)
#pragma unroll
            for (int m = 0; m < 4; ++m) { bf16_t* rowp = base + (size_t)(row0 + ai * HALF + m * 16) * ldc + col0;
#pragma unroll
                for (int bj = 0; bj < 2; ++bj) { f32x4 v0 = acc[ai][bj][m][0] + bv[bj][0], v1 = acc[ai][bj][m][1] + bv[bj][1];
                    if (ACT == 1) { f32x2 a = gelu_pk((f32x2){v0[0], v0[1]}), b = gelu_pk((f32x2){v0[2], v0[3]}), c = gelu_pk((f32x2){v1[0], v1[1]}), d = gelu_pk((f32x2){v1[2], v1[3]});
                        v0 = (f32x4){a.x, a.y, b.x, b.y}; v1 = (f32x4){c.x, c.y, d.x, d.y}; }
                    v0 = v0 * sc; v1 = v1 * sc; u32x4 w; w.x = cvt_pk_bf16(v0[0], v0[1]); w.y = cvt_pk_bf16(v0[2], v0[3]); w.z = cvt_pk_bf16(v1[0], v1[1]); w.w = cvt_pk_bf16(v1[2], v1[3]);
                    *(u32x4*)(rowp + bj * HALF) = w; } }
    }
};
template <class Epi, class Sched, bool ALIGN_EPI = false, bool SP2 = false>
__device__ __forceinline__ void gemm_phase(PG8_LAS unsigned char* lds, const Gemm g, const Sched& S, const Epi& E) {
    int tid_ = threadIdx.x; asm volatile("" : "+v"(tid_));
    const int tid = tid_, wid = __builtin_amdgcn_readfirstlane(tid >> 6), lane = tid & 63, wr = wid >> 2, wc = wid & 3, fr = lane & 15, fq = lane >> 4;
    const int K = g.K, nt = K / BK;
    unsigned voffA[2], voffB[2];
#pragma unroll
    for (int i = 0; i < 2; ++i) { int R, C; stage_rc(tid * 16 + i * 8192, R, C); const int Rb = Epi::PERM ? ((R & ~31) + perm32(R & 31)) : R;
        voffA[i] = (unsigned)(R * K + C) * 2u; voffB[i] = (unsigned)(Rb * K + C) * 2u; }
    const size_t kstep = (size_t)(BK * 2);
    const size_t hstep = (size_t)HALF * K * 2;
    const size_t tstep = 2 * hstep;
    const unsigned ldsw = (unsigned)wid * 1024u;
    const int aoff = lds_byte(wr * 64 + fr, fq * 8), boff = lds_byte(wc * 32 + fr, fq * 8);
#define PG8_SA(b, h) (((b) * 2 + (h)) * HTB)
#define PG8_SB(b, h) ((4 + (b) * 2 + (h)) * HTB)
#define PG8_STAGE(bufoff, gbase, voff) do { _Pragma("unroll") for (int _i = 0; _i < 2; ++_i) \
        __builtin_amdgcn_global_load_lds((const unsigned*)((const char*)(gbase) + (voff)[_i]), (PG8_LAS unsigned*)(lds + (bufoff) + ldsw + _i * 8192), 16, 0, 0); } while (0)
#define PG8_LDA(dst, b, h) do { _Pragma("unroll") for (int m = 0; m < 4; ++m) _Pragma("unroll") for (int k = 0; k < 2; ++k) dst[m][k] = *(const PG8_LAS bf16x8*)(lds + PG8_SA(b, h) + aoff + m * 2048 + k * 1024); } while (0)
#define PG8_LDB(dst, b, h) do { _Pragma("unroll") for (int n = 0; n < 2; ++n) _Pragma("unroll") for (int k = 0; k < 2; ++k) dst[n][k] = *(const PG8_LAS bf16x8*)(lds + PG8_SB(b, h) + boff + n * 2048 + k * 1024); } while (0)
#define PG8_MMA(ai, bj, At, Bt) do { __builtin_amdgcn_s_setprio(1); _Pragma("unroll") for (int m = 0; m < 4; ++m) _Pragma("unroll") for (int n = 0; n < 2; ++n) _Pragma("unroll") for (int k = 0; k < 2; ++k) \
        acc[ai][bj][m][n] = __builtin_amdgcn_mfma_f32_16x16x32_bf16(Bt[n][k], At[m][k], acc[ai][bj][m][n], 0, 0, 0); __builtin_amdgcn_s_setprio(0); } while (0)
#define PG8_WAIT_V(n) asm volatile("s_waitcnt vmcnt(" #n ")" ::: "memory")
#define PG8_WAIT_L(n) asm volatile("s_waitcnt lgkmcnt(" #n ")" ::: "memory")
#define PG8_BAR __builtin_amdgcn_s_barrier()
#define PG8_SCHED __builtin_amdgcn_sched_barrier(0)
    Unit cur, nxt; int ui = 0;
    if (!S.next(0, cur)) return;
    f32x4 acc[2][2][4][2];
#pragma unroll
    for (int a = 0; a < 2; ++a)
#pragma unroll
        for (int b = 0; b < 2; ++b)
#pragma unroll
            for (int m = 0; m < 4; ++m)
#pragma unroll
                for (int n = 0; n < 2; ++n) acc[a][b][m][n] = (f32x4){0.f, 0.f, 0.f, 0.f};
    bf16x8 At[4][2], B0[2][2], B1[2][2];
    const char* cA = (const char*)g.A + (size_t)cur.pm * tstep; const char* cB = (const char*)g.Bt + (size_t)cur.pn * tstep;
    S.a_ready(cur);
    if constexpr (SP2) {
        PG8_STAGE(PG8_SB(0, 0), cB, voffB); PG8_STAGE(PG8_SB(0, 1), cB + hstep, voffB); PG8_STAGE(PG8_SA(0, 0), cA, voffA); PG8_STAGE(PG8_SA(0, 1), cA + hstep, voffA);
        if (wr == 1) PG8_BAR;
        PG8_WAIT_V(2); PG8_BAR;
        PG8_STAGE(PG8_SB(1, 0), cB + kstep, voffB); PG8_STAGE(PG8_SA(1, 0), cA + kstep, voffA); PG8_STAGE(PG8_SB(1, 1), cB + hstep + kstep, voffB);
        PG8_WAIT_V(6); PG8_BAR;
    } else {
        PG8_STAGE(PG8_SB(0, 0), cB, voffB); PG8_STAGE(PG8_SA(0, 0), cA, voffA); PG8_STAGE(PG8_SB(0, 1), cB + hstep, voffB); PG8_STAGE(PG8_SA(0, 1), cA + hstep, voffA);
        if (wr == 1) PG8_BAR;
        PG8_WAIT_V(4); PG8_BAR;
        PG8_STAGE(PG8_SB(1, 0), cB + kstep, voffB); PG8_STAGE(PG8_SA(1, 0), cA + kstep, voffA); PG8_STAGE(PG8_SB(1, 1), cB + hstep + kstep, voffB);
        PG8_WAIT_V(6); PG8_BAR;
    }
    for (;;) {
        const bool has_next = S.next(ui + 1, nxt);
        const char* nA = has_next ? (const char*)g.A + (size_t)nxt.pm * tstep : cA; const char* nB = has_next ? (const char*)g.Bt + (size_t)nxt.pn * tstep : cB;
        for (int t = 0; t < nt; t += 2) {
            const bool last = (t == nt - 2);
            const char* a1 = cA + (size_t)(t + 1) * kstep;
            const char* a2 = last ? nA : cA + (size_t)(t + 2) * kstep; const char* b2 = last ? nB : cB + (size_t)(t + 2) * kstep;
            const char* a3 = a2 + kstep; const char* b3 = b2 + kstep;
            if (last && has_next) S.a_ready(nxt);
            if constexpr (SP2) {
            PG8_LDB(B0, 0, 0); PG8_LDB(B1, 0, 1); PG8_SCHED; PG8_LDA(At, 0, 0); PG8_STAGE(PG8_SA(1, 1), a1 + hstep, voffA);
            PG8_WAIT_V(8); PG8_WAIT_L(0); PG8_BAR; PG8_MMA(0, 0, At, B0); PG8_MMA(0, 1, At, B1); PG8_BAR; PG8_SCHED;
            PG8_LDA(At, 0, 1); PG8_STAGE(PG8_SB(0, 0), b2, voffB); PG8_STAGE(PG8_SB(0, 1), b2 + hstep, voffB); PG8_STAGE(PG8_SA(0, 0), a2, voffA);
            PG8_WAIT_V(8); PG8_WAIT_L(0); PG8_BAR; PG8_MMA(1, 0, At, B0); PG8_MMA(1, 1, At, B1); PG8_BAR; PG8_SCHED;
            PG8_LDB(B0, 1, 0); PG8_LDB(B1, 1, 1); PG8_SCHED; PG8_LDA(At, 1, 0); PG8_STAGE(PG8_SA(0, 1), a2 + hstep, voffA);
            PG8_WAIT_V(8); PG8_WAIT_L(0); PG8_BAR; PG8_MMA(0, 0, At, B0); PG8_MMA(0, 1, At, B1); PG8_BAR; PG8_SCHED;
            PG8_LDA(At, 1, 1); PG8_STAGE(PG8_SB(1, 0), b3, voffB); PG8_STAGE(PG8_SB(1, 1), b3 + hstep, voffB); PG8_STAGE(PG8_SA(1, 0), a3, voffA);
            PG8_WAIT_V(8); PG8_WAIT_L(0); PG8_BAR; PG8_MMA(1, 0, At, B0); PG8_MMA(1, 1, At, B1); PG8_BAR; PG8_SCHED;
            } else {
            PG8_LDB(B0, 0, 0); PG8_SCHED; PG8_LDA(At, 0, 0); PG8_STAGE(PG8_SA(1, 1), a1 + hstep, voffA);
            PG8_WAIT_L(8); PG8_BAR; PG8_WAIT_L(0); PG8_MMA(0, 0, At, B0); PG8_BAR; PG8_SCHED;
            PG8_LDB(B1, 0, 1); PG8_STAGE(PG8_SB(0, 0), b2, voffB);
            PG8_BAR; PG8_WAIT_L(0); PG8_MMA(0, 1, At, B1); PG8_BAR;
            PG8_LDA(At, 0, 1); PG8_STAGE(PG8_SA(0, 0), a2, voffA);
            PG8_BAR; PG8_WAIT_L(0); PG8_MMA(1, 0, At, B0); PG8_BAR; PG8_SCHED;
            PG8_STAGE(PG8_SB(0, 1), b2 + hstep, voffB);
            PG8_WAIT_V(6); PG8_BAR; PG8_MMA(1, 1, At, B1); PG8_BAR;
            PG8_LDB(B0, 1, 0); PG8_SCHED; PG8_LDA(At, 1, 0); PG8_STAGE(PG8_SA(0, 1), a2 + hstep, voffA);
            PG8_WAIT_L(8); PG8_BAR; PG8_WAIT_L(0); PG8_MMA(0, 0, At, B0); PG8_BAR; PG8_SCHED;
            PG8_LDB(B1, 1, 1); PG8_STAGE(PG8_SB(1, 0), b3, voffB);
            PG8_BAR; PG8_WAIT_L(0); PG8_MMA(0, 1, At, B1); PG8_BAR;
            PG8_LDA(At, 1, 1); PG8_STAGE(PG8_SA(1, 0), a3, voffA);
            PG8_BAR; PG8_WAIT_L(0); PG8_MMA(1, 0, At, B0); PG8_BAR; PG8_SCHED;
            PG8_STAGE(PG8_SB(1, 1), b3 + hstep, voffB);
            PG8_WAIT_V(6); PG8_BAR; PG8_MMA(1, 1, At, B1); PG8_BAR;
            }
        }
        if constexpr (ALIGN_EPI) { if (wr == 0) PG8_BAR; }
        if constexpr (!Epi::AFTER_DRAIN) { E(acc, cur, wr, wc, fr, fq); S.done(cur); }
        if (!has_next) break;
#pragma unroll
        for (int a = 0; a < 2; ++a)
#pragma unroll
            for (int b = 0; b < 2; ++b)
#pragma unroll
                for (int m = 0; m < 4; ++m)
#pragma unroll
                    for (int n = 0; n < 2; ++n) acc[a][b][m][n] = (f32x4){0.f, 0.f, 0.f, 0.f};
        cur = nxt; cA = nA; cB = nB; ++ui;
        if constexpr (ALIGN_EPI) { if (wr == 1) PG8_BAR; }
    }
    PG8_WAIT_V(0);
    if constexpr (!ALIGN_EPI) { if (wr == 0) PG8_BAR; }
    PG8_BAR;
    if constexpr (Epi::AFTER_DRAIN) { E.fused(acc, cur, wr, wc, fr, fq, lds, wid, lane); S.done(cur); }
#undef PG8_SA
#undef PG8_SB
#undef PG8_STAGE
#undef PG8_LDA
#undef PG8_LDB
#undef PG8_MMA
#undef PG8_WAIT_V
#undef PG8_WAIT_L
#undef PG8_BAR
#undef PG8_SCHED
}
}

#define DI __device__ __forceinline__
#define LAS __attribute__((address_space(3)))
typedef unsigned short bf16;
typedef short bf16x8 __attribute__((ext_vector_type(8)));
typedef short s16x4 __attribute__((ext_vector_type(4)));
typedef float f32x4 __attribute__((ext_vector_type(4)));
typedef float f32x16 __attribute__((ext_vector_type(16)));
typedef unsigned u32x4 __attribute__((ext_vector_type(4)));
typedef unsigned u32x2 __attribute__((ext_vector_type(2)));
typedef __bf16 bf16x2_t __attribute__((ext_vector_type(2)));
typedef float f32x2_t __attribute__((ext_vector_type(2)));
typedef LAS unsigned char* ldsp;

DI unsigned pk2(float a, float b) { f32x2_t f = {a, b}; return __builtin_bit_cast(unsigned, __builtin_convertvector(f, bf16x2_t)); }
DI float bflo(unsigned w) { return __uint_as_float(w << 16); }
DI float bfhi(unsigned w) { return __uint_as_float(w & 0xffff0000u); }
DI unsigned short f2bf1(float a) { return (unsigned short)(pk2(a, 0.f) & 0xffffu); }
DI void unpack8(const u32x4 r, float (&f)[8]) { f[0] = bflo(r.x); f[1] = bfhi(r.x); f[2] = bflo(r.y); f[3] = bfhi(r.y); f[4] = bflo(r.z); f[5] = bfhi(r.z); f[6] = bflo(r.w); f[7] = bfhi(r.w); }
DI u32x4 pack8(const float (&f)[8]) { u32x4 r; r.x = pk2(f[0], f[1]); r.y = pk2(f[2], f[3]); r.z = pk2(f[4], f[5]); r.w = pk2(f[6], f[7]); return r; }
DI int opaque_tid() { int t = threadIdx.x; asm volatile("" : "+v"(t)); return t; }
DI float ex2(float x) { return __builtin_amdgcn_exp2f(x); }
DI float gelu_t(float x) { const float u = x * (1.f + 0.044715f * x * x); return x * __builtin_amdgcn_rcpf(1.f + ex2(-2.302208198f * u)); }
DI float silu_f(float x) { return x * __builtin_amdgcn_rcpf(1.f + ex2(-1.4426950409f * x)); }
DI float wave_sum(float v) {
#pragma unroll
    for (int o = 1; o < 64; o <<= 1) v += __shfl_xor(v, o);
    return v;
}
#define LDS_WAIT() asm volatile("s_waitcnt lgkmcnt(0)" ::: "memory")
#define MFMA16(a, b, c) __builtin_amdgcn_mfma_f32_16x16x32_bf16((a), (b), (c), 0, 0, 0)
#define MFMA32(a, b, c) __builtin_amdgcn_mfma_f32_32x32x16_bf16((a), (b), (c), 0, 0, 0)

constexpr int MTOK = 16384, DM = 1024, INW = 3072, DFF = 2816, UPW = 5632, NCTX = 8192;
constexpr float EPS = 1e-6f;
enum { I_XP = 0, I_XS, I_C, I_CK, I_CV, I_SRF, I_SRB, I_CCTX, I_N1, I_WMOD, I_BMOD, I_WIN, I_SGUN, I_SGUW, I_SGUB, I_RLF, I_RLB, I_RETN,
       I_QN, I_KN, I_DLAM, I_DN, I_WOUT, I_N2, I_FUP, I_FCONV, I_FCB, I_FDN, N_IN };
constexpr size_t O_Y = 0, O_CK = 16777216, O_CV = 25165824, O_RF = 33554432, O_RB = 34603008, O_END = 35651584;
constexpr size_t MiB = 1u << 20;
constexpr size_t WS_CTR = 0, WS_TAB = 64 * 1024, WS_MODS = 128 * 1024;
constexpr size_t WS_WIN = 2 * MiB, WS_WOUT = 8 * MiB, WS_WUP = 10 * MiB, WS_WDN = 21 * MiB;
constexpr size_t WS_H = 27 * MiB, WS_Z = 59 * MiB, WS_Q = 155 * MiB, WS_KCTX = 171 * MiB, WS_KSMP = 179 * MiB, WS_VTCTX = 189 * MiB, WS_VTSMP = 197 * MiB, WS_RS = 207 * MiB;
constexpr size_t WS_UP = 59 * MiB, WS_G = 147 * MiB, WS_END = 256 * MiB;
constexpr size_t WS_H2 = 203 * MiB;
constexpr size_t WS_SS = 1 * MiB, WS_SHW = 236 * MiB, WS_ZERO_BYTES = 1 * MiB + 3 * 65536;
constexpr size_t WS_WIN1 = 237 * MiB, WS_WOUT1 = 243 * MiB, WS_WUP1 = 245 * MiB;
constexpr size_t SHW_SET = 9 * 5632;

constexpr int LDS_MAIN = 131072, LDS_BYTES = LDS_MAIN + 1024;
constexpr int NPH = 23;

struct Params { const float* in[N_IN]; float* out; unsigned char* ws; int ph_lo, ph_hi, coop, pad; };

struct EpiResid {
    static constexpr bool PERM = false, AFTER_DRAIN = false;
    const float* x_ctx; const float* x_smp; float* out; const float* gate;
    __device__ __forceinline__ void operator()(const pg8::f32x4 (&acc)[2][2][4][2], const pg8::Unit& u, int wr, int wc, int fr, int fq) const {
        const int pm = u.pm; const int j = pm < 32 ? 0 : 1 + ((pm - 32) >> 2);
        const float* xs = pm < 32 ? x_ctx + (size_t)pm * 256 * DM : x_smp + (size_t)(pm - 32) * 256 * DM;
        float* o = out + (size_t)pm * 256 * DM;
        const int col0 = u.pn * 256 + wc * 32 + 4 * fq;
        pg8::f32x4 gv[2][2];
#pragma unroll
        for (int bj = 0; bj < 2; ++bj)
#pragma unroll
            for (int n = 0; n < 2; ++n) gv[bj][n] = *(const pg8::f32x4*)(gate + (size_t)j * 6144 + col0 + bj * 128 + n * 16);
#pragma unroll
        for (int ai = 0; ai < 2; ++ai)
#pragma unroll
            for (int m = 0; m < 4; ++m) { const size_t roff = (size_t)(ai * 128 + wr * 64 + m * 16 + fr) * DM + col0;
#pragma unroll
                for (int bj = 0; bj < 2; ++bj)
#pragma unroll
                    for (int n = 0; n < 2; ++n) { const size_t off = roff + bj * 128 + n * 16;
                        const pg8::f32x4 xv = *(const pg8::f32x4*)(xs + off); *(pg8::f32x4*)(o + off) = xv + gv[bj][n] * acc[ai][bj][m][n]; } }
    }
};

template <int MODE> struct EpiResidFold {
    static constexpr bool PERM = false, AFTER_DRAIN = false;
    const float* x_ctx; const float* x_smp; float* out; const float* gate; const float* nw; const float* scb; bf16* xp; float* SS;
    __device__ __forceinline__ void operator()(const pg8::f32x4 (&acc)[2][2][4][2], const pg8::Unit& u, int wr, int wc, int fr, int fq) const {
        const int pm = u.pm; const int j = pm < 32 ? 0 : 1 + ((pm - 32) >> 2);
        const float* xs = pm < 32 ? x_ctx + (size_t)pm * 256 * DM : x_smp + (size_t)(pm - 32) * 256 * DM;
        float* o = out + (size_t)pm * 256 * DM; bf16* xq = xp + (size_t)pm * 256 * DM;
        bf16* xb = (bf16*)(out + (pm < 32 ? O_CK + (size_t)(2 * pm + 1) * 131072 : O_CV + (size_t)(2 * (pm - 32) + 1) * 131072));
        const int col0 = u.pn * 256 + wc * 32 + 4 * fq;
#pragma unroll
        for (int ai = 0; ai < 2; ++ai)
#pragma unroll
            for (int m = 0; m < 4; ++m) { const int lrow = ai * 128 + wr * 64 + m * 16 + fr; const size_t roff = (size_t)lrow * DM + col0; float ssq = 0.f;
                pg8::f32x4 xv[2][2], gv[2][2];
#pragma unroll
                for (int bj = 0; bj < 2; ++bj)
#pragma unroll
                    for (int n = 0; n < 2; ++n) gv[bj][n] = *(const pg8::f32x4*)(gate + (size_t)j * 6144 + col0 + bj * 128 + n * 16);
#pragma unroll
                for (int bj = 0; bj < 2; ++bj)
#pragma unroll
                    for (int n = 0; n < 2; ++n) { if (MODE == 2) { const u32x2 r = *(const u32x2*)(xb + roff + bj * 128 + n * 16); xv[bj][n] = (pg8::f32x4){bflo(r.x), bfhi(r.x), bflo(r.y), bfhi(r.y)}; }
                        else xv[bj][n] = *(const pg8::f32x4*)(xs + roff + bj * 128 + n * 16); }
#pragma unroll
                for (int bj = 0; bj < 2; ++bj)
#pragma unroll
                    for (int n = 0; n < 2; ++n) { const size_t off = roff + bj * 128 + n * 16; const int c = col0 + bj * 128 + n * 16;
                        const pg8::f32x4 y = xv[bj][n] + gv[bj][n] * acc[ai][bj][m][n];
                        if (MODE == 1) { u32x2 yb; yb.x = pk2(y[0], y[1]); yb.y = pk2(y[2], y[3]); *(u32x2*)(xb + off) = yb; } else *(pg8::f32x4*)(o + off) = y;
                        ssq += (y[0] * y[0] + y[1] * y[1]) + (y[2] * y[2] + y[3] * y[3]);
                        const pg8::f32x4 av = *(const pg8::f32x4*)(nw + c) * (*(const pg8::f32x4*)(scb + (size_t)j * 6144 + c) + 1.f);
                        const pg8::f32x4 q = y * av; u32x2 w; w.x = pk2(q[0], q[1]); w.y = pk2(q[2], q[3]); *(u32x2*)(xq + off) = w; }
                ssq += __shfl_xor(ssq, 16); ssq += __shfl_xor(ssq, 32);
                if (fq == 0) __hip_atomic_fetch_add(SS + (size_t)pm * 256 + lrow, ssq, __ATOMIC_RELAXED, __HIP_MEMORY_SCOPE_AGENT);
                asm volatile("" ::: "memory"); }
    }
};
struct EpiBf16Fold {
    static constexpr bool PERM = true, AFTER_DRAIN = false;
    bf16* O; int ldc; const float* SS; const float* bias; int N; int pm_off;
    __device__ __forceinline__ void operator()(const pg8::f32x4 (&acc)[2][2][4][2], const pg8::Unit& u, int wr, int wc, int fr, int fq) const {
        const int gpm = u.pm + pm_off; const int j = gpm < 32 ? 0 : 1 + ((gpm - 32) >> 2);
        const int row0 = u.pm * 256 + wr * 64 + fr, col0 = u.pn * 256 + wc * 32 + 8 * fq;
        pg8::f32x4 bv[2][2];
#pragma unroll
        for (int bj = 0; bj < 2; ++bj)
#pragma unroll
            for (int n = 0; n < 2; ++n) bv[bj][n] = *(const pg8::f32x4*)(bias + (size_t)j * N + col0 + bj * 128 + 4 * n);
        float rs[2][4];
#pragma unroll
        for (int ai = 0; ai < 2; ++ai)
#pragma unroll
            for (int m = 0; m < 4; ++m) rs[ai][m] = SS[(size_t)(row0 + ai * 128 + m * 16) + (size_t)pm_off * 256];
#pragma unroll
        for (int ai = 0; ai < 2; ++ai)
#pragma unroll
            for (int m = 0; m < 4; ++m) { const int lrow = row0 + ai * 128 + m * 16; const float rstd = rsqrtf(rs[ai][m] * (1.f / DM) + EPS);
                bf16* rowp = O + (size_t)lrow * ldc + col0;
#pragma unroll
                for (int bj = 0; bj < 2; ++bj) { const pg8::f32x4 v0 = acc[ai][bj][m][0] * rstd + bv[bj][0], v1 = acc[ai][bj][m][1] * rstd + bv[bj][1];
                    u32x4 w; w.x = pk2(v0[0], v0[1]); w.y = pk2(v0[2], v0[3]); w.z = pk2(v1[0], v1[1]); w.w = pk2(v1[2], v1[3]);
                    *(u32x4*)(rowp + bj * 128) = w; } }
    }
};

template <typename T> DI float ld_as_f32(const T* p);
template <> DI float ld_as_f32<float>(const float* p) { return *p; }
template <> DI float ld_as_f32<bf16>(const bf16* p) { return __uint_as_float((unsigned)(*p) << 16); }
template <typename T> DI void tr_item(const T* src, size_t ld_s, bf16* dst, size_t ld_d, LAS float* scr, int lane) {
    if constexpr (sizeof(T) == 4) {
        f32x4 v[8]; const int rr = lane >> 3, c4 = (lane & 7) * 4;
#pragma unroll
        for (int i = 0; i < 8; ++i) v[i] = *(const f32x4*)((const float*)src + (size_t)(8 * i + rr) * ld_s + c4);
#pragma unroll
        for (int i = 0; i < 8; ++i) { LAS float* d = scr + (8 * i + rr) * 33 + c4; d[0] = v[i][0]; d[1] = v[i][1]; d[2] = v[i][2]; d[3] = v[i][3]; }
    } else {
#pragma unroll 8
        for (int i = 0; i < 32; ++i) { const int kk = 2 * i + (lane >> 5); scr[kk * 33 + (lane & 31)] = ld_as_f32<T>(src + (size_t)kk * ld_s + (lane & 31)); }
    }
    LDS_WAIT();
    const int c = lane & 7;
#pragma unroll
    for (int j = 0; j < 4; ++j) { const int n = (lane >> 3) + 8 * j; const LAS float* s = scr + (8 * c) * 33 + n;
        u32x4 o; o.x = pk2(s[0 * 33], s[1 * 33]); o.y = pk2(s[2 * 33], s[3 * 33]); o.z = pk2(s[4 * 33], s[5 * 33]); o.w = pk2(s[6 * 33], s[7 * 33]);
        *(u32x4*)(dst + (size_t)n * ld_d + 8 * c) = o; }
    LDS_WAIT();
}

DI void gemv9_unit(ldsp lds, const float* v0, const float* v1, int vstride, bool act, const float* W, int N, const float* bvec, float* out, int n0, int ncols = 64) {
    LAS float* S = (LAS float*)lds;
    LAS float* RED = (LAS float*)(lds + 9 * 1024 * 4);
    const int tid = opaque_tid();
    for (int i = tid; i < 9 * 1024; i += 512) { const int j = i >> 10, k = i & 1023; const float v = j == 0 ? v0[k] : v1[(size_t)(j - 1) * vstride + k]; S[i] = act ? silu_f(v) : v; }
    __syncthreads();
    const int cq = tid & 15, kg = tid >> 4; const bool act_col = 4 * cq < ncols;
    const float* w = W + ((size_t)kg * 32) * N + n0 + (act_col ? 4 * cq : 0);
    f32x4 acc[9];
#pragma unroll
    for (int j = 0; j < 9; ++j) acc[j] = (f32x4){0.f, 0.f, 0.f, 0.f};
#pragma unroll 1
    for (int k0 = 0; k0 < 32; k0 += 8) {
        f32x4 wv[8];
#pragma unroll
        for (int k = 0; k < 8; ++k) wv[k] = *(const f32x4*)(w + (size_t)(k0 + k) * N);
#pragma unroll
        for (int k = 0; k < 8; ++k)
#pragma unroll
            for (int j = 0; j < 9; ++j) acc[j] += wv[k] * S[j * 1024 + kg * 32 + k0 + k];
    }
#pragma unroll
    for (int j = 0; j < 9; ++j) *(LAS f32x4*)(RED + (kg * 9 + j) * 64 + 4 * cq) = acc[j];
    __syncthreads();
    for (int o = tid; o < 576; o += 512) { const int j = o >> 6, cc = o & 63; if (cc >= ncols) continue; float sm = bvec ? bvec[n0 + cc] : 0.f;
#pragma unroll 8
        for (int g = 0; g < 32; ++g) sm += RED[(g * 9 + j) * 64 + cc];
        out[(size_t)j * N + n0 + cc] = sm; }
    __syncthreads();
}
DI void phase_mods(const Params& P, ldsp lds) {
    float* mods = (float*)(P.ws + WS_MODS);
    for (int u = blockIdx.x; u < 256; u += gridDim.x) { const int l = u / 128, n0 = (u % 128) * 48;
        gemv9_unit(lds, P.in[I_CCTX], P.in[I_C], 1024, true, P.in[I_WMOD] + (size_t)l * 1024 * 6144, 6144, P.in[I_BMOD] + l * 6144, mods + (size_t)l * 9 * 6144, n0, 48); }
}
DI void phase_shw(const Params& P, ldsp lds) {
    const float* mods = (const float*)(P.ws + WS_MODS); float* shw = (float*)(P.ws + WS_SHW);
    for (int u = blockIdx.x; u < 224; u += gridDim.x) {
        if (u < 88) gemv9_unit(lds, mods + 3072, mods + 6144 + 3072, 6144, false, P.in[I_FUP], 5632, nullptr, shw, u * 64);
        else if (u < 136) gemv9_unit(lds, mods + 9 * 6144, mods + 10 * 6144, 6144, false, P.in[I_WIN] + (size_t)1024 * 3072, 3072, nullptr, shw + SHW_SET, (u - 88) * 64);
        else gemv9_unit(lds, mods + 9 * 6144 + 3072, mods + 10 * 6144 + 3072, 6144, false, P.in[I_FUP] + (size_t)1024 * 5632, 5632, nullptr, shw + 2 * SHW_SET, (u - 136) * 64);
    }
}
DI void phase_tables(const Params& P) {
    if (blockIdx.x != 0) return;
    const int tid = opaque_tid();
    float* tab = (float*)(P.ws + WS_TAB);
    for (int i = tid; i < 1024; i += 512) {
        const int pos = i >> 4, fi = i & 15;
        const float inv = exp2f(-(float)fi * (13.287712379549449f / 16.f));
        const float angf = (float)pos * inv;
        double x = (double)angf; const double kk = rint(x * 0.15915494309189535); x -= kk * 6.283185307179586;
        const double x2 = x * x; double ts = x, sn = x, tc = 1.0, cs = 1.0;
#pragma unroll 1
        for (int n = 1; n <= 14; ++n) { ts *= -x2 / (double)((2 * n) * (2 * n + 1)); sn += ts; tc *= -x2 / (double)((2 * n - 1) * (2 * n)); cs += tc; }
        tab[i * 2] = (float)cs; tab[i * 2 + 1] = (float)sn;
    }
}
DI void phase_prep(const Params& P, int l, ldsp lds, int mask, int blk0 = 0, int nblk = 0, int par = -1) {
    const int tid = opaque_tid(), lane = tid & 63, wid = tid >> 6;
    const int gw = ((int)blockIdx.x - blk0) * 8 + wid, NGW = (nblk ? nblk : (int)gridDim.x) * 8;
    LAS float* scr = (LAS float*)(lds + wid * 16384);
    constexpr int I1 = 16 * 96, I2 = 16 * 32, I3 = 16 * 176, I4 = 44 * 32, I5 = 512;
    const float* w_in = P.in[I_WIN] + (size_t)l * 1024 * 3072; const float* w_out = P.in[I_WOUT] + (size_t)l * 1024 * 1024;
    const float* w_up = P.in[I_FUP] + (size_t)l * 1024 * 5632; const float* w_dn = P.in[I_FDN] + (size_t)l * 2816 * 1024;
    bf16* win_t = (bf16*)(P.ws + (l ? WS_WIN1 : WS_WIN)); bf16* wout_t = (bf16*)(P.ws + (l ? WS_WOUT1 : WS_WOUT)); bf16* wup_t = (bf16*)(P.ws + (l ? WS_WUP1 : WS_WUP));
    if (mask & 1) for (int it = gw; it < I1 + I2 + I3; it += NGW) {
        int r = it; if (par >= 0 && ((it / NGW) & 1) != par) continue;
        if (r < I1) { const int kb = r / 96, nb = r % 96; tr_item<float>(w_in + (size_t)(64 * kb) * 3072 + 32 * nb, 3072, win_t + (size_t)(32 * nb) * 1024 + 64 * kb, 1024, scr, lane); continue; } r -= I1;
        if (r < I2) { const int kb = r / 32, nb = r % 32; tr_item<float>(w_out + (size_t)(64 * kb) * 1024 + 32 * nb, 1024, wout_t + (size_t)(32 * nb) * 1024 + 64 * kb, 1024, scr, lane); continue; } r -= I2;
        { const int kb = r / 176, nb = r % 176; tr_item<float>(w_up + (size_t)(64 * kb) * 5632 + 32 * nb, 5632, wup_t + (size_t)(32 * nb) * 1024 + 64 * kb, 1024, scr, lane); }
    }
    if (mask & 2) for (int r = gw; r < I4; r += NGW) { const int kb = r / 32, nb = r % 32; tr_item<float>(w_dn + (size_t)(64 * kb) * 1024 + 32 * nb, 1024, (bf16*)(P.ws + WS_WDN) + (size_t)(32 * nb) * 2816 + 64 * kb, 2816, scr, lane); }
    if (mask & 4) {
        for (int r = gw; r < I5; r += NGW) { const int b = r >> 6, rem = r & 63, keyblk = rem >> 4, cb = rem & 15;
            tr_item<float>(P.in[I_CV] + ((size_t)(b * 2 + l) * 256 + 64 * keyblk) * 512 + 32 * cb, 512, (bf16*)(P.ws + WS_VTSMP) + ((size_t)b * 512 + 32 * cb) * 1280 + 64 * keyblk, 1280, scr, lane); }
        bf16* ksmp = (bf16*)(P.ws + WS_KSMP);
        for (int i = blockIdx.x * 512 + tid; i < 131072; i += gridDim.x * 512) {
            const int e0 = i * 8, b = e0 >> 17, rem = e0 & 131071, key = rem >> 9, col = rem & 511, h = col >> 7, c128 = col & 127;
            const float* src = P.in[I_CK] + ((size_t)(b * 2 + l) * 256 + key) * 512 + col;
            const f32x4 a = *(const f32x4*)src, c = *(const f32x4*)(src + 4);
            u32x4 o; o.x = pk2(a[0], a[1]); o.y = pk2(a[2], a[3]); o.z = pk2(c[0], c[1]); o.w = pk2(c[2], c[3]);
            *(u32x4*)(ksmp + ((size_t)(b * 4 + h) * 1280 + key) * 128 + c128) = o;
        }
    }
}
DI void phase_norm(const Params& P, const float* __restrict__ x_ctx, const float* __restrict__ x_smp, const float* __restrict__ nw, const float* __restrict__ mods_l, int sh_off, int sc_off) {
    const int tid = opaque_tid(), lane = tid & 63, wid = tid >> 6;
    const int gw = blockIdx.x * 8 + wid, NGW = gridDim.x * 8;
    bf16* __restrict__ H = (bf16*)(P.ws + WS_H);
    for (int mb = gw; mb < MTOK; mb += 4 * NGW) {
        f32x4 v[4][4];
#pragma unroll
        for (int r = 0; r < 4; ++r) { const int m = mb + r * NGW;
            if (m < MTOK) { const float* xr = m < NCTX ? x_ctx + (size_t)m * DM : x_smp + (size_t)(m - NCTX) * DM;
#pragma unroll
                for (int q = 0; q < 4; ++q) v[r][q] = *((const f32x4*)xr + lane + 64 * q); } }
#pragma unroll
        for (int r = 0; r < 4; ++r) { const int m = mb + r * NGW;
            if (m < MTOK) {
                const int j = m < NCTX ? 0 : 1 + ((m - NCTX) >> 10);
                const float* md = mods_l + (size_t)j * 6144;
                float ss = 0.f;
#pragma unroll
                for (int q = 0; q < 4; ++q) ss += (v[r][q][0] * v[r][q][0] + v[r][q][1] * v[r][q][1]) + (v[r][q][2] * v[r][q][2] + v[r][q][3] * v[r][q][3]);
                const float rstd = rsqrtf(wave_sum(ss) * (1.f / DM) + EPS);
#pragma unroll
                for (int q = 0; q < 4; ++q) { const int col = 4 * (lane + 64 * q);
                    const f32x4 w = *(const f32x4*)(nw + col), sc = *(const f32x4*)(md + sc_off + col), sh = *(const f32x4*)(md + sh_off + col);
                    const f32x4 y = (v[r][q] * rstd) * w * (sc + 1.f) + sh;
                    u32x2 o; o.x = pk2(y[0], y[1]); o.y = pk2(y[2], y[3]);
                    *(u32x2*)(H + (size_t)m * DM + col) = o; } } }
    }
}
DI int next_unit(unsigned* ctr, ldsp lds) {
    LAS int* slot = (LAS int*)(lds + LDS_MAIN);
    __syncthreads();
    if (opaque_tid() == 0) *slot = (int)atomicAdd(ctr, 1u);
    __syncthreads();
    return *slot;
}
DI void sgu_unit(const Params& P, int l, int ck, ldsp lds, int gh) {
    const int tid = opaque_tid(), lane = tid & 63, wid = tid >> 6, fr = lane & 15, fq = lane >> 4;
    const bf16* Z = (const bf16*)(P.ws + WS_Z); bf16* YC = (bf16*)(P.ws + WS_H);
    const size_t m0 = (size_t)ck * 128;
    ldsp VnT = lds; ldsp WsL = lds + 256 * 272;
    const float* gn = P.in[I_SGUN] + l * 256;
    {   const int cc = tid & 31, r0 = tid >> 5;
        float gnv[8];
#pragma unroll
        for (int e = 0; e < 8; ++e) gnv[e] = gn[8 * cc + e];
        u32x4 raws[8];
#pragma unroll
        for (int i = 0; i < 8; ++i) raws[i] = *(const u32x4*)(Z + (m0 + r0 + 16 * i) * INW + 256 + 8 * cc);
#pragma unroll
        for (int i = 0; i < 8; ++i) { const int q = r0 + 16 * i;
            const u32x4 raw = raws[i];
            float f[8]; unpack8(raw, f); float ss = 0.f;
#pragma unroll
            for (int e = 0; e < 8; ++e) { f[e] = gelu_t(f[e]); ss += f[e] * f[e]; }
            ss += __shfl_xor(ss, 1); ss += __shfl_xor(ss, 2); ss += __shfl_xor(ss, 4); ss += __shfl_xor(ss, 8); ss += __shfl_xor(ss, 16);
            const float rstd = rsqrtf(ss * (1.f / 256.f) + EPS);
            if ((cc >> 4) == gh) {
#pragma unroll
                for (int e = 0; e < 8; ++e) *(LAS bf16*)(VnT + (8 * cc + e) * 272 + (q ^ ((cc & 7) << 3)) * 2) = f2bf1(f[e] * rstd * gnv[e]); }
        }
    }
    f32x4 wpre[8];
    {   const f32x4* ws_g = (const f32x4*)(P.in[I_SGUW] + ((size_t)(l * 4 + 2 * gh) * 128) * 128);
#pragma unroll
        for (int i = 0; i < 8; ++i) wpre[i] = ws_g[tid + 512 * i]; }
    for (int g = 2 * gh; g < 2 * gh + 2; ++g) {
#pragma unroll
        for (int i = 0; i < 8; ++i) { const int idx = tid + 512 * i, p = idx >> 5, q4 = idx & 31;
            u32x2 o; o.x = pk2(wpre[i][0], wpre[i][1]); o.y = pk2(wpre[i][2], wpre[i][3]);
            *(LAS u32x2*)(WsL + p * 272 + q4 * 8) = o; }
        __syncthreads();
        if (g < 2 * gh + 1) { const f32x4* ws_g = (const f32x4*)(P.in[I_SGUW] + ((size_t)(l * 4 + g + 1) * 128) * 128);
#pragma unroll
            for (int i = 0; i < 8; ++i) wpre[i] = ws_g[tid + 512 * i]; }
        const int p = 16 * wid + fr; const float bias = P.in[I_SGUB][(l * 4 + g) * 128 + p];
        u32x2 zu[4];
#pragma unroll
        for (int mi = 0; mi < 4; ++mi) zu[mi] = *(const u32x2*)(Z + (m0 + p) * INW + 64 * g + 16 * mi + 4 * fq);
        f32x4 acc[4];
#pragma unroll
        for (int mi = 0; mi < 4; ++mi) acc[mi] = (f32x4){0.f, 0.f, 0.f, 0.f};
#pragma unroll
        for (int ks = 0; ks < 4; ++ks) { const bf16x8 bw = *(const LAS bf16x8*)(WsL + (16 * wid + fr) * 272 + (32 * ks + 8 * fq) * 2);
#pragma unroll
            for (int mi = 0; mi < 4; ++mi) { const bf16x8 av = *(const LAS bf16x8*)(VnT + (64 * g + 16 * mi + fr) * 272 + ((32 * ks + 8 * fq) ^ (((2 * mi + (fr >> 3)) & 7) << 3)) * 2); acc[mi] = MFMA16(av, bw, acc[mi]); } }
#pragma unroll
        for (int mi = 0; mi < 4; ++mi) { const int c0 = 64 * g + 16 * mi + 4 * fq;
            const float y0 = gelu_t(bflo(zu[mi].x)) * (acc[mi][0] + bias), y1 = gelu_t(bfhi(zu[mi].x)) * (acc[mi][1] + bias), y2 = gelu_t(bflo(zu[mi].y)) * (acc[mi][2] + bias), y3 = gelu_t(bfhi(zu[mi].y)) * (acc[mi][3] + bias);
            u32x2 o; o.x = pk2(y0, y1); o.y = pk2(y2, y3);
            *(u32x2*)(YC + (m0 + p) * DM + c0) = o; }
        __syncthreads();
    }
}
DI float log2_sigmoid(float x) { return -log1pf(__expf(-x)) * 1.4426950408889634f; }
DI void rets_unit(const Params& P, int l, int ru, ldsp lds) {
    const int tid = opaque_tid(), lane = tid & 63, wid = tid >> 6, fr = lane & 15, fq = lane >> 4;
    const bf16* Z = (const bf16*)(P.ws + WS_Z); float* RS = (float*)(P.ws + WS_RS);
    const int gck = ru >> 2, h = ru & 3; const size_t m0 = (size_t)gck * 128;
    const float lgf = log2_sigmoid(P.in[I_RLF][l * 4 + h]), lgb = log2_sigmoid(P.in[I_RLB][l * 4 + h]);
    ldsp KfT = lds, KbT = lds + 17408, VT = lds + 34816;
    {   const int cc = tid & 7, pr = tid >> 3;
#pragma unroll
        for (int i = 0; i < 2; ++i) { const int p = pr + 64 * i;
            const u32x4 kr = *(const u32x4*)(Z + (m0 + p) * INW + 768 + 64 * h + 8 * cc), vr = *(const u32x4*)(Z + (m0 + p) * INW + 1024 + 64 * h + 8 * cc);
            float kf[8], vf[8]; unpack8(kr, kf); unpack8(vr, vf);
            const float df = ex2((float)(127 - p) * lgf) * 0.125f, db = ex2((float)p * lgb) * 0.125f;
#pragma unroll
            for (int e = 0; e < 8; ++e) { const int d = 8 * cc + e;
                const int ps = (p ^ ((cc & 3) << 3)) * 2;
                *(LAS bf16*)(KfT + d * 272 + ps) = f2bf1(kf[e] * df); *(LAS bf16*)(KbT + d * 272 + ps) = f2bf1(kf[e] * db); *(LAS bf16*)(VT + d * 272 + ps) = f2bf1(vf[e]); } }
    }
    __syncthreads();
    const int dir = wid >> 2, dblk = wid & 3; ldsp KT = dir ? KbT : KfT;
    f32x4 acc[4];
#pragma unroll
    for (int mi = 0; mi < 4; ++mi) acc[mi] = (f32x4){0.f, 0.f, 0.f, 0.f};
#pragma unroll
    for (int ks = 0; ks < 4; ++ks) { const bf16x8 bk = *(const LAS bf16x8*)(KT + (16 * dblk + fr) * 272 + (32 * ks + 8 * (fq ^ ((2 * dblk + (fr >> 3)) & 3))) * 2);
#pragma unroll
        for (int mi = 0; mi < 4; ++mi) { const bf16x8 av = *(const LAS bf16x8*)(VT + (16 * mi + fr) * 272 + (32 * ks + 8 * (fq ^ ((2 * mi + (fr >> 3)) & 3))) * 2); acc[mi] = MFMA16(av, bk, acc[mi]); } }
    float* dst = RS + ((size_t)ru * 2 + dir) * 4096 + (16 * dblk + fr) * 64;
#pragma unroll
    for (int mi = 0; mi < 4; ++mi) *(f32x4*)(dst + 16 * mi + 4 * fq) = acc[mi];
}
DI void reto_unit(const Params& P, int l, int ru, ldsp lds) {
    const int tid = opaque_tid(), lane = tid & 63, wid = tid >> 6, fr = lane & 15, fq = lane >> 4;
    const bf16* Z = (const bf16*)(P.ws + WS_Z); const float* RS = (const float*)(P.ws + WS_RS); bf16* YC = (bf16*)(P.ws + WS_H);
    const int gck = ru >> 2, h = ru & 3; const size_t m0 = (size_t)gck * 128;
    const bool ctx = gck < 64;
    const int b = ctx ? (gck >> 1) : ((gck - 64) >> 3), n = ctx ? (gck & 1) : ((gck - 64) & 7), N = ctx ? 2 : 8;
    const float lgf = log2_sigmoid(P.in[I_RLF][l * 4 + h]), lgb = log2_sigmoid(P.in[I_RLB][l * 4 + h]);
    const float Gf = ex2(128.f * lgf), Gb = ex2(128.f * lgb);
    ldsp QL = lds, KL = lds + 18432, VT = lds + 36864, RfT = lds + 54272, RbT = lds + 63488;
    u32x4 qkv[2][3];
    {   const int cc = tid & 7, pr = tid >> 3;
#pragma unroll
        for (int i = 0; i < 2; ++i) { const bf16* zr = Z + (m0 + pr + 64 * i) * INW + 64 * h + 8 * cc; qkv[i][0] = *(const u32x4*)(zr + 512); qkv[i][1] = *(const u32x4*)(zr + 768); qkv[i][2] = *(const u32x4*)(zr + 1024); } }
    {
        const int d = tid >> 3, e0 = (tid & 7) * 8;
        float rf[8], rb[8];
        if (ctx) {
#pragma unroll
            for (int e = 0; e < 8; ++e) { rf[e] = 0.f; rb[e] = 0.f; }
        } else {
            const float* sf = P.in[I_SRF] + ((size_t)((b * 2 + l) * 4 + h)) * 4096 + d * 64 + e0; const float* sb = P.in[I_SRB] + ((size_t)((b * 2 + l) * 4 + h)) * 4096 + d * 64 + e0;
#pragma unroll
            for (int e = 0; e < 8; ++e) { rf[e] = sf[e]; rb[e] = sb[e]; }
        }
        {   f32x4 sv[7][2];
#pragma unroll
            for (int m = 0; m < 7; ++m) if (m < n) { const float* s = RS + ((size_t)(((gck - n + m) << 2) | h) * 2 + 0) * 4096 + d * 64 + e0; sv[m][0] = *(const f32x4*)s; sv[m][1] = *(const f32x4*)(s + 4); }
#pragma unroll
            for (int m = 0; m < 7; ++m) if (m < n) {
#pragma unroll
                for (int e = 0; e < 8; ++e) rf[e] = rf[e] * Gf + sv[m][e >> 2][e & 3]; }
        }
        {   f32x4 sv[7][2];
#pragma unroll
            for (int q = 0; q < 7; ++q) { const int m = N - 1 - q; if (m > n) { const float* s = RS + ((size_t)(((gck - n + m) << 2) | h) * 2 + 1) * 4096 + d * 64 + e0; sv[q][0] = *(const f32x4*)s; sv[q][1] = *(const f32x4*)(s + 4); } }
#pragma unroll
            for (int q = 0; q < 7; ++q) { const int m = N - 1 - q; if (m > n) {
#pragma unroll
                for (int e = 0; e < 8; ++e) rb[e] = rb[e] * Gb + sv[q][e >> 2][e & 3]; } }
        }
#pragma unroll
        for (int e = 0; e < 8; ++e) { const int ds = (d ^ (((tid & 7) & 3) << 3)) * 2; *(LAS bf16*)(RfT + (e0 + e) * 144 + ds) = f2bf1(rf[e]); *(LAS bf16*)(RbT + (e0 + e) * 144 + ds) = f2bf1(rb[e]); }
        if (ctx && n == N - 1) { const float* s = RS + ((size_t)ru * 2 + 0) * 4096 + d * 64 + e0; float* o = P.out + O_RF + ((size_t)((b * 2 + l) * 4 + h)) * 4096 + d * 64 + e0;
#pragma unroll
            for (int e = 0; e < 8; ++e) o[e] = rf[e] * Gf + s[e]; }
        if (ctx && n == 0) { const float* s = RS + ((size_t)ru * 2 + 1) * 4096 + d * 64 + e0; float* o = P.out + O_RB + ((size_t)((b * 2 + l) * 4 + h)) * 4096 + d * 64 + e0;
#pragma unroll
            for (int e = 0; e < 8; ++e) o[e] = rb[e] * Gb + s[e]; }
    }
    {   const int cc = tid & 7, pr = tid >> 3;
#pragma unroll
        for (int i = 0; i < 2; ++i) { const int p = pr + 64 * i;
            const u32x4 qr = qkv[i][0], kr = qkv[i][1], vr = qkv[i][2];
            *(LAS u32x4*)(QL + p * 144 + 16 * cc) = qr; *(LAS u32x4*)(KL + p * 144 + 16 * cc) = kr;
            const int ps = (p ^ ((cc & 3) << 3)) * 2;
            *(LAS bf16*)(VT + (8 * cc + 0) * 272 + ps) = (bf16)(vr.x & 0xffffu); *(LAS bf16*)(VT + (8 * cc + 1) * 272 + ps) = (bf16)(vr.x >> 16);
            *(LAS bf16*)(VT + (8 * cc + 2) * 272 + ps) = (bf16)(vr.y & 0xffffu); *(LAS bf16*)(VT + (8 * cc + 3) * 272 + ps) = (bf16)(vr.y >> 16);
            *(LAS bf16*)(VT + (8 * cc + 4) * 272 + ps) = (bf16)(vr.z & 0xffffu); *(LAS bf16*)(VT + (8 * cc + 5) * 272 + ps) = (bf16)(vr.z >> 16);
            *(LAS bf16*)(VT + (8 * cc + 6) * 272 + ps) = (bf16)(vr.w & 0xffffu); *(LAS bf16*)(VT + (8 * cc + 7) * 272 + ps) = (bf16)(vr.w >> 16); }
    }
    __syncthreads();
    bf16x8 qfr[2];
#pragma unroll
    for (int ks = 0; ks < 2; ++ks) qfr[ks] = *(const LAS bf16x8*)(QL + (16 * wid + fr) * 144 + (32 * ks + 8 * fq) * 2);
    f32x4 a1[8];
#pragma unroll
    for (int jb = 0; jb < 8; ++jb) { a1[jb] = (f32x4){0.f, 0.f, 0.f, 0.f};
#pragma unroll
        for (int ks = 0; ks < 2; ++ks) { const bf16x8 kf = *(const LAS bf16x8*)(KL + (16 * jb + fr) * 144 + (32 * ks + 8 * fq) * 2); a1[jb] = MFMA16(kf, qfr[ks], a1[jb]); } }
    const int pl = 16 * wid + fr;
#pragma unroll
    for (int jb = 0; jb < 8; ++jb)
#pragma unroll
        for (int r = 0; r < 4; ++r) { const int dl = pl - (16 * jb + 4 * fq + r);
            const float fdl = (float)dl;
            const float D = ex2(fmaxf(fdl, 0.f) * lgf + fmaxf(-fdl, 0.f) * lgb) + fmaxf(1.f - fabsf(fdl), 0.f);
            a1[jb][r] *= D * 0.125f; }
    f32x4 a2[4], aF[4], aB[4];
#pragma unroll
    for (int eb = 0; eb < 4; ++eb) { a2[eb] = (f32x4){0.f, 0.f, 0.f, 0.f}; aF[eb] = a2[eb]; aB[eb] = a2[eb]; }
#pragma unroll
    for (int k2 = 0; k2 < 4; ++k2) {
        u32x4 pw; pw.x = pk2(a1[2 * k2][0], a1[2 * k2][1]); pw.y = pk2(a1[2 * k2][2], a1[2 * k2][3]); pw.z = pk2(a1[2 * k2 + 1][0], a1[2 * k2 + 1][1]); pw.w = pk2(a1[2 * k2 + 1][2], a1[2 * k2 + 1][3]);
        const bf16x8 pb = __builtin_bit_cast(bf16x8, pw);
#pragma unroll
        for (int eb = 0; eb < 4; ++eb) { const int gx = ((2 * eb + (fr >> 3)) & 3) << 3; const s16x4 lo = *(const LAS s16x4*)(VT + (16 * eb + fr) * 272 + (32 * k2 + ((4 * fq) ^ gx)) * 2), hi = *(const LAS s16x4*)(VT + (16 * eb + fr) * 272 + (32 * k2 + ((16 + 4 * fq) ^ gx)) * 2);
            const bf16x8 va = __builtin_shufflevector(lo, hi, 0, 1, 2, 3, 4, 5, 6, 7); a2[eb] = MFMA16(va, pb, a2[eb]); }
    }
#pragma unroll
    for (int ks = 0; ks < 2; ++ks)
#pragma unroll
        for (int eb = 0; eb < 4; ++eb) { const int rx = (32 * ks + 8 * fq) ^ (((2 * eb + (fr >> 3)) & 3) << 3); const bf16x8 rfv = *(const LAS bf16x8*)(RfT + (16 * eb + fr) * 144 + rx * 2), rbv = *(const LAS bf16x8*)(RbT + (16 * eb + fr) * 144 + rx * 2);
            aF[eb] = MFMA16(rfv, qfr[ks], aF[eb]); aB[eb] = MFMA16(rbv, qfr[ks], aB[eb]); }
    const float qdf = ex2((float)(pl + 1) * lgf), qdb = ex2((float)(128 - pl) * lgb);
    float ss = 0.f;
#pragma unroll
    for (int eb = 0; eb < 4; ++eb) { a2[eb] = a2[eb] + aF[eb] * qdf + aB[eb] * qdb; ss += (a2[eb][0] * a2[eb][0] + a2[eb][1] * a2[eb][1]) + (a2[eb][2] * a2[eb][2] + a2[eb][3] * a2[eb][3]); }
    ss += __shfl_xor(ss, 16); ss += __shfl_xor(ss, 32);
    const float rstd = rsqrtf(ss * (1.f / 64.f) + EPS);
    const float* rn = P.in[I_RETN] + (l * 4 + h) * 64;
#pragma unroll
    for (int eb = 0; eb < 4; ++eb) { const int e0 = 16 * eb + 4 * fq;
        const u32x2 gr = *(const u32x2*)(Z + (m0 + pl) * INW + 1280 + 64 * h + e0); const f32x4 w = *(const f32x4*)(rn + e0);
        const float y0 = a2[eb][0] * rstd * w[0] * silu_f(bflo(gr.x)), y1 = a2[eb][1] * rstd * w[1] * silu_f(bfhi(gr.x)), y2 = a2[eb][2] * rstd * w[2] * silu_f(bflo(gr.y)), y3 = a2[eb][3] * rstd * w[3] * silu_f(bfhi(gr.y));
        u32x2 o; o.x = pk2(y0, y1); o.y = pk2(y2, y3);
        *(u32x2*)(YC + (m0 + pl) * DM + 256 + 64 * h + e0) = o; }
}
DI void cprep_unit(const Params& P, int l, int cu, ldsp lds) {
    const int tid = opaque_tid();
    const bf16* Z = (const bf16*)(P.ws + WS_Z); bf16* Q = (bf16*)(P.ws + WS_Q); const float* tab = (const float*)(P.ws + WS_TAB);
    const int m0 = cu * 64; const bool ctx = m0 < NCTX;
    const int b = ctx ? (m0 >> 8) : ((m0 - NCTX) >> 10), t0 = ctx ? (m0 & 255) : ((m0 - NCTX) & 1023);
    {   const int c = tid & 7, gs = tid >> 3;
        u32x4 raws[16];
#pragma unroll
        for (int i = 0; i < 16; ++i) { const int item = gs + 64 * i, tok = item >> 4, grp = item & 15; raws[i] = *(const u32x4*)(Z + (size_t)(m0 + tok) * INW + 1536 + grp * 64 + 8 * c); }
#pragma unroll
        for (int i = 0; i < 16; ++i) { const int item = gs + 64 * i, tok = item >> 4, grp = item & 15, m = m0 + tok, t = t0 + tok;
            const u32x4 raw = raws[i];
            float f[8]; unpack8(raw, f); float ss = 0.f;
#pragma unroll
            for (int e = 0; e < 8; ++e) ss += f[e] * f[e];
            ss += __shfl_xor(ss, 1); ss += __shfl_xor(ss, 2); ss += __shfl_xor(ss, 4);
            const float rstd = rsqrtf(ss * (1.f / 64.f) + EPS);
            const float* gp = (grp >> 3) ? P.in[I_KN] + l * 64 + 8 * c : P.in[I_QN] + l * 64 + 8 * c;
            float y[8];
#pragma unroll
            for (int e = 0; e < 8; ++e) y[e] = f[e] * rstd * gp[e];
            if (!ctx) { const int pos = (c < 4) ? (t >> 6) : (t & 63); const float* tp = tab + (pos * 16 + (c & 1) * 8) * 2; const bool first = (c & 2) == 0;
#pragma unroll
                for (int e = 0; e < 8; ++e) { const float pr = __shfl_xor(y[e], 2); const float cs = tp[2 * e], sn = tp[2 * e + 1];
                    y[e] = first ? (y[e] * cs - pr * sn) : (pr * sn + y[e] * cs); } }
            if (grp < 8) {
#pragma unroll
                for (int e = 0; e < 8; ++e) y[e] *= 0.18033688011112042f;
                *(u32x4*)(Q + (size_t)m * 512 + grp * 64 + 8 * c) = pack8(y);
            } else { const int g2 = grp - 8, h = g2 >> 1, half = g2 & 1;
                bf16* kd = ctx ? (bf16*)(P.ws + WS_KCTX) + ((size_t)(b * 4 + h) * 256 + t) * 128 + half * 64 + 8 * c : (bf16*)(P.ws + WS_KSMP) + ((size_t)(b * 4 + h) * 1280 + 256 + t) * 128 + half * 64 + 8 * c;
                *(u32x4*)kd = pack8(y);
                if (ctx) { float* ok = P.out + O_CK + ((size_t)(b * 2 + l) * 256 + t) * 512 + g2 * 64 + 8 * c; *(f32x4*)ok = (f32x4){y[0], y[1], y[2], y[3]}; *(f32x4*)(ok + 4) = (f32x4){y[4], y[5], y[6], y[7]}; } }
        }
    }
    ldsp VL = lds;
    u32x4 vraws[8];
#pragma unroll
    for (int i = 0; i < 8; ++i) { const int id = tid + 512 * i, tok = id >> 6, cc = id & 63; vraws[i] = *(const u32x4*)(Z + (size_t)(m0 + tok) * INW + 2560 + 8 * cc); }
#pragma unroll
    for (int i = 0; i < 8; ++i) { const int id = tid + 512 * i, tok = id >> 6, cc = id & 63;
        const u32x4 raw = vraws[i];
        *(LAS u32x4*)(VL + tok * 1040 + 16 * (cc ^ ((tok >> 3) & 7))) = raw;
        if (ctx) { float f[8]; unpack8(raw, f); float* ov = P.out + O_CV + ((size_t)(b * 2 + l) * 256 + t0 + tok) * 512 + 8 * cc; *(f32x4*)ov = (f32x4){f[0], f[1], f[2], f[3]}; *(f32x4*)(ov + 4) = (f32x4){f[4], f[5], f[6], f[7]}; } }
    __syncthreads();
#pragma unroll 2
    for (int i = 0; i < 8; ++i) { const int id = tid + 512 * i, kc = id & 7, col = id >> 3;
        unsigned short v[8];
#pragma unroll
        for (int e = 0; e < 8; ++e) v[e] = *(const LAS bf16*)(VL + (8 * kc + e) * 1040 + 16 * ((col >> 3) ^ kc) + (col & 7) * 2);
        u32x4 o; o.x = v[0] | ((unsigned)v[1] << 16); o.y = v[2] | ((unsigned)v[3] << 16); o.z = v[4] | ((unsigned)v[5] << 16); o.w = v[6] | ((unsigned)v[7] << 16);
        bf16* vd = ctx ? (bf16*)(P.ws + WS_VTCTX) + ((size_t)b * 512 + col) * 256 + t0 + 8 * kc : (bf16*)(P.ws + WS_VTSMP) + ((size_t)b * 512 + col) * 1280 + 256 + t0 + 8 * kc;
        *(u32x4*)vd = o; }
}
DI void attn_unit(const Params& P, int l, int au, ldsp lds, float lam, float osc) {
    const int tid = opaque_tid(), lane = tid & 63, wid = tid >> 6, r32 = lane & 31, hh = lane >> 5, rg = wid & 3, kg = wid >> 2;
    int b, h, qrow0, np, ldvt; const bf16 *Kb, *VTb;
    if (au < 256) { b = au >> 5; h = (au >> 3) & 3; const int qb = au & 7; qrow0 = NCTX + b * 1024 + qb * 128; np = 10; ldvt = 1280;
        Kb = (const bf16*)(P.ws + WS_KSMP) + ((size_t)(b * 4 + h) * 1280) * 128; VTb = (const bf16*)(P.ws + WS_VTSMP) + ((size_t)(b * 4 + h) * 128) * 1280; }
    else { const int a2 = au - 256; b = a2 >> 3; h = (a2 >> 1) & 3; qrow0 = b * 256 + 128 * (a2 & 1); np = 2; ldvt = 256;
        Kb = (const bf16*)(P.ws + WS_KCTX) + ((size_t)(b * 4 + h) * 256) * 128; VTb = (const bf16*)(P.ws + WS_VTCTX) + ((size_t)(b * 4 + h) * 128) * 256; }
    ldsp KL = lds + kg * 17408; ldsp VL = lds + 34816 + kg * 18432;
    ldsp ST = lds + 73728;
    const bf16* qp = (const bf16*)(P.ws + WS_Q) + (size_t)(qrow0 + 32 * rg + r32) * 512 + h * 128;
    bf16x8 qf[2][4];
#pragma unroll
    for (int i = 0; i < 2; ++i)
#pragma unroll
        for (int s = 0; s < 4; ++s) qf[i][s] = *(const bf16x8*)(qp + i * 64 + 16 * s + 8 * hh);
    u32x4 kreg[4], vreg[4];
    float mm[2] = {-INFINITY, -INFINITY}, ll[2] = {0.f, 0.f};
#define LOADK(tp) do { _Pragma("unroll") for (int _i = 0; _i < 4; ++_i) { const int _id = tid + 512 * _i; kreg[_i] = *(const u32x4*)(Kb + (size_t)(128 * (tp) + (_id >> 4)) * 128 + 8 * (_id & 15)); } } while (0)
#define LOADV(tp) do { _Pragma("unroll") for (int _i = 0; _i < 4; ++_i) { const int _id = tid + 512 * _i; vreg[_i] = *(const u32x4*)(VTb + (size_t)((_id >> 3) & 127) * ldvt + 128 * (tp) + 64 * (_id >> 10) + 8 * (_id & 7)); } } while (0)
#define STOREK() do { _Pragma("unroll") for (int _i = 0; _i < 4; ++_i) { const int _id = tid + 512 * _i; *(LAS u32x4*)(lds + (_id >> 10) * 17408 + ((_id >> 4) & 63) * 272 + 16 * (_id & 15)) = kreg[_i]; } } while (0)
#define STOREV() do { _Pragma("unroll") for (int _i = 0; _i < 4; ++_i) { const int _id = tid + 512 * _i; *(LAS u32x4*)(lds + 34816 + (_id >> 10) * 18432 + ((_id >> 3) & 127) * 144 + 16 * (_id & 7)) = vreg[_i]; } } while (0)
    LOADK(0);
    for (int tp = 0; tp < np; ++tp) {
        __syncthreads(); STOREK(); __syncthreads();
        if (tp + 1 < np) LOADK(tp + 1);
#pragma unroll
        for (int i = 0; i < 2; ++i) {
            f32x16 s0, s1;
#pragma unroll
            for (int r = 0; r < 16; ++r) { s0[r] = 0.f; s1[r] = 0.f; }
#pragma unroll
            for (int s = 0; s < 4; ++s) { const bf16x8 k0 = *(const LAS bf16x8*)(KL + r32 * 272 + (64 * i + 16 * s + 8 * hh) * 2), k1 = *(const LAS bf16x8*)(KL + (32 + r32) * 272 + (64 * i + 16 * s + 8 * hh) * 2);
                s0 = MFMA32(k0, qf[i][s], s0); s1 = MFMA32(k1, qf[i][s], s1); }
            float mx = s0[0];
#pragma unroll
            for (int r = 0; r < 16; ++r) mx = fmaxf(mx, fmaxf(s0[r], s1[r]));
            mx = fmaxf(mx, __shfl_xor(mx, 32));
            const float mn = fmaxf(mm[i], mx); float sum = 0.f;
#pragma unroll
            for (int r = 0; r < 16; ++r) sum += ex2(s0[r] - mn) + ex2(s1[r] - mn);
            ll[i] = ll[i] * ex2(mm[i] - mn) + sum; mm[i] = mn;
        }
    }
    ll[0] += __shfl_xor(ll[0], 32); ll[1] += __shfl_xor(ll[1], 32);
    if (hh == 0) {
#pragma unroll
        for (int i = 0; i < 2; ++i) *(LAS f32x2_t*)(ST + (((kg * 4 + rg) * 2 + i) * 32 + r32) * 8) = (f32x2_t){mm[i], ll[i]};
    }
    LOADK(0); LOADV(0);
    __syncthreads();
    float nb[2];
#pragma unroll
    for (int i = 0; i < 2; ++i) { const f32x2_t o2 = *(const LAS f32x2_t*)(ST + ((((1 - kg) * 4 + rg) * 2 + i) * 32 + r32) * 8);
        const float M = fmaxf(mm[i], o2[0]); const float L = ll[i] * ex2(mm[i] - M) + o2[1] * ex2(o2[0] - M); nb[i] = -(M + __builtin_amdgcn_logf(L)); }
    nb[1] += __builtin_amdgcn_logf(fabsf(lam));
    const float lsgn = lam < 0.f ? -1.f : 1.f;
    f32x16 o[4];
#pragma unroll
    for (int d = 0; d < 4; ++d)
#pragma unroll
        for (int r = 0; r < 16; ++r) o[d][r] = 0.f;
    for (int tp = 0; tp < np; ++tp) {
        __syncthreads(); STOREK(); STOREV(); __syncthreads();
        if (tp + 1 < np) { LOADK(tp + 1); LOADV(tp + 1); }
#pragma unroll
        for (int kb = 0; kb < 2; ++kb) {
            f32x16 pa, s1;
#pragma unroll
            for (int r = 0; r < 16; ++r) { pa[r] = nb[0]; s1[r] = nb[1]; }
#pragma unroll
            for (int s = 0; s < 4; ++s) { const bf16x8 kf = *(const LAS bf16x8*)(KL + (32 * kb + r32) * 272 + (16 * s + 8 * hh) * 2); pa = MFMA32(kf, qf[0][s], pa); }
#pragma unroll
            for (int s = 0; s < 4; ++s) { const bf16x8 kf = *(const LAS bf16x8*)(KL + (32 * kb + r32) * 272 + (64 + 16 * s + 8 * hh) * 2); s1 = MFMA32(kf, qf[1][s], s1); }
#pragma unroll
            for (int r = 0; r < 16; ++r) pa[r] = ex2(pa[r]) - lsgn * ex2(s1[r]);
#pragma unroll
            for (int sp = 0; sp < 2; ++sp) { const int ks = 2 * kb + sp;
                u32x4 pw; pw.x = pk2(pa[8 * sp + 0], pa[8 * sp + 1]); pw.y = pk2(pa[8 * sp + 2], pa[8 * sp + 3]); pw.z = pk2(pa[8 * sp + 4], pa[8 * sp + 5]); pw.w = pk2(pa[8 * sp + 6], pa[8 * sp + 7]);
                const bf16x8 pb = __builtin_bit_cast(bf16x8, pw);
#pragma unroll
                for (int d = 0; d < 4; ++d) { const s16x4 lo = *(const LAS s16x4*)(VL + (32 * d + r32) * 144 + (16 * ks + 4 * hh) * 2), hi = *(const LAS s16x4*)(VL + (32 * d + r32) * 144 + (16 * ks + 8 + 4 * hh) * 2);
                    const bf16x8 va = __builtin_shufflevector(lo, hi, 0, 1, 2, 3, 4, 5, 6, 7); o[d] = MFMA32(va, pb, o[d]); }
            }
        }
    }
#undef LOADK
#undef LOADV
#undef STOREK
#undef STOREV
    __syncthreads();
    ldsp OX = lds + (32 * rg + r32) * 528;
    if (kg == 1) {
#pragma unroll
        for (int d = 0; d < 4; ++d)
#pragma unroll
            for (int g4 = 0; g4 < 4; ++g4) *(LAS f32x4*)(OX + (32 * d + 8 * g4 + 4 * hh) * 4) = (f32x4){o[d][4 * g4 + 0], o[d][4 * g4 + 1], o[d][4 * g4 + 2], o[d][4 * g4 + 3]};
    }
    __syncthreads();
    if (kg == 0) {
        float ss = 0.f;
#pragma unroll
        for (int d = 0; d < 4; ++d)
#pragma unroll
            for (int g4 = 0; g4 < 4; ++g4) { const f32x4 t = *(const LAS f32x4*)(OX + (32 * d + 8 * g4 + 4 * hh) * 4);
#pragma unroll
                for (int e = 0; e < 4; ++e) { o[d][4 * g4 + e] += t[e]; ss += o[d][4 * g4 + e] * o[d][4 * g4 + e]; } }
        ss += __shfl_xor(ss, 32);
        const float rstd = rsqrtf(ss * (1.f / 128.f) + EPS) * osc;
        const float* dn = P.in[I_DN] + l * 128;
        bf16* dst = (bf16*)(P.ws + WS_H) + (size_t)(qrow0 + 32 * rg + r32) * DM + 512 + h * 128;
#pragma unroll
        for (int d = 0; d < 4; ++d)
#pragma unroll
            for (int g4 = 0; g4 < 4; ++g4) { const int d0 = 32 * d + 8 * g4 + 4 * hh; const f32x4 w = *(const f32x4*)(dn + d0);
                u32x2 ov; ov.x = pk2(o[d][4 * g4 + 0] * rstd * w[0], o[d][4 * g4 + 1] * rstd * w[1]); ov.y = pk2(o[d][4 * g4 + 2] * rstd * w[2], o[d][4 * g4 + 3] * rstd * w[3]);
                *(u32x2*)(dst + d0) = ov; }
    }
}
DI void unpack8v(const u32x4 r, f32x2_t (&f)[4]) { f[0] = (f32x2_t){bflo(r.x), bfhi(r.x)}; f[1] = (f32x2_t){bflo(r.y), bfhi(r.y)}; f[2] = (f32x2_t){bflo(r.z), bfhi(r.z)}; f[3] = (f32x2_t){bflo(r.w), bfhi(r.w)}; }
DI void phase_convgate(const Params& P, int l, int hf) {
    const bf16* __restrict__ UP = (const bf16*)(P.ws + WS_UP); bf16* __restrict__ Gb = (bf16*)(P.ws + WS_G) + (size_t)hf * 8192 * DFF;
    const int seqlen = hf ? 1024 : 256;
    const float* __restrict__ cw = P.in[I_FCONV] + (size_t)l * 3 * UPW; const float* __restrict__ cb = P.in[I_FCB] + (size_t)l * UPW;
    const int nitems = 1024 * 352;
    for (int it = blockIdx.x * 512 + opaque_tid(); it < nitems; it += gridDim.x * 512) {
        const int strip = it / 352, ch = it % 352, n0 = 8 * ch, r0 = strip * 8, t0 = r0 % seqlen;
        u32x4 ra[10], rb[10];
        const bool has_prev = t0 != 0, has_next = (t0 + 8) != seqlen;
#pragma unroll
        for (int i = 0; i < 10; ++i) { const int r = r0 - 1 + i; const bool ok = (i == 0) ? has_prev : ((i == 9) ? has_next : true);
            if (ok) { ra[i] = *(const u32x4*)(UP + (size_t)r * UPW + n0); rb[i] = *(const u32x4*)(UP + (size_t)r * UPW + DFF + n0); }
            else { ra[i] = (u32x4){0u, 0u, 0u, 0u}; rb[i] = ra[i]; } }
        f32x2_t wa[3][4], wb[3][4], ba[4], bb[4];
#pragma unroll
        for (int j = 0; j < 3; ++j)
#pragma unroll
            for (int q = 0; q < 4; ++q) { wa[j][q] = *(const f32x2_t*)(cw + j * UPW + n0 + 2 * q); wb[j][q] = *(const f32x2_t*)(cw + j * UPW + DFF + n0 + 2 * q); }
#pragma unroll
        for (int q = 0; q < 4; ++q) { ba[q] = *(const f32x2_t*)(cb + n0 + 2 * q); bb[q] = *(const f32x2_t*)(cb + DFF + n0 + 2 * q); }
        f32x2_t pa[4], pb[4], ca[4], cbv[4], na[4], nb[4];
        unpack8v(ra[0], pa); unpack8v(rb[0], pb); unpack8v(ra[1], ca); unpack8v(rb[1], cbv);
#pragma unroll
        for (int rr = 0; rr < 8; ++rr) { const int r = r0 + rr;
            unpack8v(ra[rr + 2], na); unpack8v(rb[rr + 2], nb);
            u32x4 o; unsigned ow[4];
#pragma unroll
            for (int q = 0; q < 4; ++q) { const f32x2_t ya = wa[0][q] * pa[q] + wa[1][q] * ca[q] + wa[2][q] * na[q] + ba[q], yb = wb[0][q] * pb[q] + wb[1][q] * cbv[q] + wb[2][q] * nb[q] + bb[q];
                const f32x2_t tt = ya * -1.4426950409f; f32x2_t e; e.x = ex2(tt.x); e.y = ex2(tt.y); e = e + 1.f;
                f32x2_t rc; rc.x = __builtin_amdgcn_rcpf(e.x); rc.y = __builtin_amdgcn_rcpf(e.y);
                const f32x2_t g = (ya * rc) * yb; ow[q] = pk2(g.x, g.y);
                pa[q] = ca[q]; pb[q] = cbv[q]; ca[q] = na[q]; cbv[q] = nb[q]; }
            o.x = ow[0]; o.y = ow[1]; o.z = ow[2]; o.w = ow[3];
            *(u32x4*)(Gb + (size_t)r * DFF + n0) = o; }
    }
}

#define XB_TMO      128
#define XB_XCNT(j)  (256  + 64 * (j))
#define XB_XSUB(j)  (1280 + 64 * (j))
#define XB_XGEN(j)  (2304 + 64 * (j))
#define XB_TOP      3328
#define XB_TOPGEN   3392
#define XCD_BAR_WORDS 3456
#define XB_SPIN_CAP (1u << 18)

__device__ __forceinline__ unsigned xb_ld(unsigned* p)              { return __hip_atomic_load(p, __ATOMIC_RELAXED, __HIP_MEMORY_SCOPE_AGENT); }
__device__ __forceinline__ unsigned xb_add(unsigned* p, unsigned v) { return __hip_atomic_fetch_add(p, v, __ATOMIC_RELAXED, __HIP_MEMORY_SCOPE_AGENT); }
__device__ __forceinline__ unsigned xb_xcc_id() { return (unsigned)__builtin_amdgcn_s_getreg((3 << 11) | 20) & 0xFu; }
#define XB_SPIN(cond, bar) do { unsigned _sp = 0; while (cond) { __builtin_amdgcn_s_sleep(1); \
    if ((++_sp & 255u) == 0u) { if (xb_ld(&(bar)[XB_TMO])) break; if (_sp > XB_SPIN_CAP) { atomicAdd(&(bar)[XB_TMO], 1u); break; } } } } while (0)

struct XcdBarrier {
    unsigned* bar; unsigned x;
    volatile LAS unsigned* st;
};

__device__ __forceinline__ XcdBarrier xcd_barrier_post(unsigned* bar, volatile LAS unsigned* st) {
    XcdBarrier b; b.bar = bar; b.x = xb_xcc_id(); b.st = st;
    if (threadIdx.x == 0) (void)xb_add(&bar[XB_XCNT(b.x)], 1u);
    return b;
}
__device__ __forceinline__ void xcd_barrier_complete(unsigned* bar, unsigned x, unsigned& nloc, unsigned& nx) {
    const unsigned G = gridDim.x * gridDim.y * gridDim.z;
    unsigned sum, cnt, mine, sp = 0u;
    for (;;) {
        sum = 0u; cnt = 0u; mine = 0u;
#pragma unroll
        for (unsigned j = 0; j < 16; ++j) { const unsigned c = xb_ld(&bar[XB_XCNT(j)]); sum += c; cnt += (c > 0u) ? 1u : 0u; mine = (j == x) ? c : mine; }
        if (sum == G) break;
        __builtin_amdgcn_s_sleep(1);
        if ((++sp & 255u) == 0u) { if (xb_ld(&bar[XB_TMO])) break; if (sp > XB_SPIN_CAP) { atomicAdd(&bar[XB_TMO], 1u); break; } }
    }
    nloc = mine > 0u ? mine : 1u; nx = cnt > 0u ? cnt : 1u;
}

__device__ __forceinline__ void xcd_barrier(const XcdBarrier& b) {
    asm volatile("s_waitcnt vmcnt(0)" ::: "memory");
    __syncthreads();
    if (threadIdx.x == 0) {
        unsigned* bar = b.bar;
        __builtin_amdgcn_s_waitcnt(0);
        unsigned nloc = b.st[0], nx = b.st[1];
        if (nloc == 0u) { xcd_barrier_complete(bar, b.x, nloc, nx); b.st[0] = nloc; b.st[1] = nx; }
        const unsigned old = xb_add(&bar[XB_XSUB(b.x)], 1u);
        const unsigned gen = old / nloc;
        if (old + 1u == (gen + 1u) * nloc) {
            __builtin_amdgcn_fence(__ATOMIC_RELEASE, "agent");
            asm volatile("s_waitcnt vmcnt(0)" ::: "memory");
            const unsigned og = xb_add(&bar[XB_TOP], 1u);
            const unsigned tg = og / nx;
            if (og + 1u == (tg + 1u) * nx) xb_add(&bar[XB_TOPGEN], 1u);
            else XB_SPIN(xb_ld(&bar[XB_TOPGEN]) == tg, bar);
            __builtin_amdgcn_fence(__ATOMIC_ACQUIRE, "agent");
            xb_add(&bar[XB_XGEN(b.x)], 1u);
            asm volatile("s_waitcnt vmcnt(0)" ::: "memory");
        } else {
            XB_SPIN(xb_ld(&bar[XB_XGEN(b.x)]) == gen, bar);
            __builtin_amdgcn_fence(__ATOMIC_ACQUIRE, "agent");
            asm volatile("s_waitcnt vmcnt(0)" ::: "memory");
        }
    }
    __syncthreads();
}

constexpr size_t WS_BAR = 16 * 1024;
#ifndef EN_G1
#define EN_G1 1
#endif
#ifndef EN_G2
#define EN_G2 1
#endif
#ifndef EN_MA
#define EN_MA 1
#endif
#ifndef EN_MB
#define EN_MB 1
#endif
#ifndef EN_AT
#define EN_AT 1
#endif
#ifndef EN_RO
#define EN_RO 1
#endif
#ifndef EN_CG
#define EN_CG 1
#endif
#ifndef DUP_MASK
#define DUP_MASK 0
#endif
#ifndef DUP_SKIP
#define DUP_SKIP 0
#endif
#define REPS(k) (((DUP_MASK >> (k)) & 1) ? 2 : 1)
#define REPLOOP(k) _Pragma("unroll") for (int rep = 0; rep < REPS(k); ++rep)
#define REPSYNC(k) do { if (rep + 1 < REPS(k)) xcd_barrier(xbar); } while (0)
#define IN(k) (lo <= (k) && (k) < hi)
#ifndef SYNC_REPS
#define SYNC_REPS 1
#endif
#define SEAM(k) do { if (IN(k) && IN((k) + 1)) { for (int _s = 0; _s < SYNC_REPS; ++_s) xcd_barrier(xbar); } } while (0)
template <int L> DI void layer_phases(const Params& P, ldsp lds, const int lo, const int hi, const XcdBarrier& xbar) {
    constexpr int B = 1 + 11 * L;
    const int G = gridDim.x;
    const float* mods_l = (const float*)(P.ws + WS_MODS) + (size_t)L * 9 * 6144;
    const bf16* win_t = (const bf16*)(P.ws + (L ? WS_WIN1 : WS_WIN)); const bf16* wout_t = (const bf16*)(P.ws + (L ? WS_WOUT1 : WS_WOUT)); const bf16* wup_t = (const bf16*)(P.ws + (L ? WS_WUP1 : WS_WUP));
    float* SS2 = (float*)(P.ws + WS_SS) + (L == 0 ? 0 : 2) * 16384; float* SS1 = (float*)(P.ws + WS_SS) + 16384; const float* shw = (const float*)(P.ws + WS_SHW);
    if (L == 0) {
        if (IN(B + 0)) REPLOOP(12) { phase_norm(P, P.in[I_XP], P.in[I_XS], P.in[I_N1], mods_l, 0, 1024); __syncthreads(); phase_shw(P, lds); REPSYNC(12); }
        SEAM(B + 0);
    }
    if (EN_G1 && IN(B + 1)) REPLOOP(1) {
        pg8::Gemm g{(const bf16*)(P.ws + WS_H), win_t, MTOK, INW, DM};
        pg8::StaticOrder S; S.init(MTOK, INW, G, (int)blockIdx.x);
        if (L == 0) { pg8::EpiBf16<0> E{(bf16*)(P.ws + WS_Z), INW, nullptr, 0, 0, 1.f}; pg8::gemm_phase<pg8::EpiBf16<0>, pg8::StaticOrder, true, true>(lds, g, S, E); }
        else { EpiBf16Fold E{(bf16*)(P.ws + WS_Z), INW, SS1, shw + SHW_SET, INW, 0}; pg8::gemm_phase<EpiBf16Fold, pg8::StaticOrder, true, true>(lds, g, S, E); }
        REPSYNC(1);
    }
    SEAM(B + 1);
    if (EN_MA && IN(B + 2)) REPLOOP(2) {
        if (L > 0) phase_prep(P, L, lds, 2 | 4);
        __syncthreads();
        for (int vb = blockIdx.x; vb < 256; vb += G) {
            sgu_unit(P, L, vb >> 1, lds, vb & 1); __syncthreads();
            cprep_unit(P, L, vb, lds); __syncthreads();
            rets_unit(P, L, 2 * vb, lds); __syncthreads(); rets_unit(P, L, 2 * vb + 1, lds); __syncthreads();
        }
        REPSYNC(2);
    }
    SEAM(B + 2);
    if (EN_MB && IN(B + 3)) REPLOOP(3) {
        unsigned* ctr = (unsigned*)(P.ws + WS_CTR) + (B + 3) + 32 * rep;
        const float* dl = P.in[I_DLAM] + L * 256; const int lane = opaque_tid() & 63;
        const float s1 = wave_sum(dl[lane] * dl[64 + lane]), s2 = wave_sum(dl[128 + lane] * dl[192 + lane]);
        const float lam_init = L == 0 ? 0.2f : 0.35550906759f;
        const float lam = expf(s1) - expf(s2) + lam_init;
        if (EN_AT && !(rep == 1 && (DUP_SKIP & 1))) {
#pragma unroll 1
            for (int pass = 0; pass < 2; ++pass)
#pragma unroll 1
                for (int vb = blockIdx.x; vb < 256; vb += G) { const int x = vb & 7, sl = vb >> 3;
                    const int u = pass == 0 ? (4 * x + (sl >> 3)) * 8 + (sl & 7) : 256 + (16 * x + (sl >> 1)) * 2 + (sl & 1);
                    __syncthreads(); attn_unit(P, L, u, lds, lam, 1.f - lam_init); }
        }
        if (EN_RO && !(rep == 1 && (DUP_SKIP & 2))) for (int u = blockIdx.x; u < 512; u += G) { __syncthreads(); reto_unit(P, L, u, lds); }
        REPSYNC(3);
    }
    SEAM(B + 3);
    if (EN_G2 && IN(B + 4)) {
        pg8::Gemm g{(const bf16*)(P.ws + WS_H), wout_t, MTOK, DM, DM};
        EpiResidFold<L == 0 ? 1 : 0> E{L == 0 ? P.in[I_XP] : P.out, L == 0 ? P.in[I_XS] : P.out + (size_t)NCTX * DM, P.out, mods_l + 2048, P.in[I_N2] + L * DM, mods_l + 4096, (bf16*)(P.ws + WS_H2), SS2};
        pg8::StaticOrder S; S.init(MTOK, DM, G, (int)blockIdx.x);
        pg8::gemm_phase<EpiResidFold<L == 0 ? 1 : 0>, pg8::StaticOrder, true, true>(lds, g, S, E);
    }
    SEAM(B + 4);
#pragma unroll
    for (int hf = 0; hf < 2; ++hf) {
        if (EN_G1 && IN(B + 6 + 2 * hf)) REPLOOP(6) {
            pg8::Gemm g{(const bf16*)(P.ws + WS_H2) + (size_t)hf * 8192 * DM, wup_t, 8192, UPW, DM};
            EpiBf16Fold E{(bf16*)(P.ws + WS_UP), UPW, SS2, shw + (L == 0 ? 0 : 2 * SHW_SET), UPW, 32 * hf};
            pg8::StaticOrder S; S.init(8192, UPW, G, (int)blockIdx.x);
            pg8::gemm_phase<EpiBf16Fold, pg8::StaticOrder, true, true>(lds, g, S, E);
            if (L == 0 && rep == 0 && G == 256 && blockIdx.x >= 192) { __syncthreads(); phase_prep(P, 1, lds, 1, 192, 64, hf); }
            REPSYNC(6);
        }
        SEAM(B + 6 + 2 * hf);
        if (EN_CG && IN(B + 7 + 2 * hf)) REPLOOP(7) { phase_convgate(P, L, hf); REPSYNC(7); }
        SEAM(B + 7 + 2 * hf);
    }
    if (EN_G2 && IN(B + 10)) {
        pg8::Gemm g{(const bf16*)(P.ws + WS_G), (const bf16*)(P.ws + WS_WDN), MTOK, DM, DFF};
        pg8::StaticOrder S; S.init(MTOK, DM, G, (int)blockIdx.x);
        if (L == 0) {
            const float* mods_n = (const float*)(P.ws + WS_MODS) + (size_t)9 * 6144;
            EpiResidFold<2> E{P.out, P.out + (size_t)NCTX * DM, P.out, mods_l + 5120, P.in[I_N1] + DM, mods_n + 1024, (bf16*)(P.ws + WS_H), SS1};
            pg8::gemm_phase<EpiResidFold<2>, pg8::StaticOrder, true, true>(lds, g, S, E);
        } else { EpiResid E{P.out, P.out + (size_t)NCTX * DM, P.out, mods_l + 5120}; pg8::gemm_phase<EpiResid, pg8::StaticOrder, true, true>(lds, g, S, E); }
    }
    if (L == 0) SEAM(B + 10);
}
__global__ void __launch_bounds__(512, 2) mk_fwd(Params P) {
    extern __shared__ __attribute__((aligned(16))) unsigned char lds_raw[];
    ldsp lds = (ldsp)lds_raw;
    cg::grid_group grid = cg::this_grid();
    const int lo = P.ph_lo, hi = P.ph_hi;
    if (threadIdx.x < 8) ((LAS unsigned*)(lds + LDS_MAIN))[threadIdx.x] = 0u;
    __syncthreads();
    unsigned* barw = (unsigned*)(P.ws + WS_BAR);
    if (P.coop == 2) grid.sync();
    XcdBarrier xbar; xbar.bar = barw; xbar.x = 0; xbar.st = nullptr;
    if (hi - lo > 1) xbar = xcd_barrier_post(barw, (volatile LAS unsigned*)(lds + LDS_MAIN + 16));
    if (IN(0)) REPLOOP(11) { phase_tables(P); phase_mods(P, lds); __syncthreads(); phase_prep(P, 0, lds, 1 | 2 | 4); if (gridDim.x != 256) phase_prep(P, 1, lds, 1); REPSYNC(11); }
    SEAM(0);
    layer_phases<0>(P, lds, lo, hi, xbar);
    layer_phases<1>(P, lds, lo, hi, xbar);
}
#undef IN
#undef SEAM

extern "C" void kernel_launch(void* const* d_in, const int* in_sizes, int n_in, void* d_out, int out_size, void* d_ws, size_t ws_size, hipStream_t stream) {
    static int grid = 0;
    if (grid == 0) {
        if (n_in != N_IN || (size_t)out_size != O_END || ws_size < WS_END) { fprintf(stderr, "kernel_launch: unexpected sizes n_in %d out %d ws %zu\n", n_in, out_size, ws_size); grid = -1; return; }
        int dev = 0, cus = 0, per_cu = 0;
        if (hipGetDevice(&dev) != hipSuccess || hipDeviceGetAttribute(&cus, hipDeviceAttributeMultiprocessorCount, dev) != hipSuccess) { grid = -1; return; }
        if (hipFuncSetAttribute((const void*)mk_fwd, hipFuncAttributeMaxDynamicSharedMemorySize, LDS_BYTES) != hipSuccess) { fprintf(stderr, "kernel_launch: hipFuncSetAttribute failed\n"); grid = -1; return; }
        if (hipOccupancyMaxActiveBlocksPerMultiprocessor(&per_cu, (const void*)mk_fwd, 512, LDS_BYTES) != hipSuccess || per_cu < 1) { per_cu = 1; (void)hipGetLastError(); }
        grid = cus * 1;
    }
    if (grid < 0) return;
    if (hipMemsetAsync(d_ws, 0, WS_ZERO_BYTES, stream) != hipSuccess) { fprintf(stderr, "kernel_launch: memset failed\n"); return; }
    Params p{};
    for (int i = 0; i < N_IN; ++i) p.in[i] = (const float*)d_in[i];
    p.out = (float*)d_out; p.ws = (unsigned char*)d_ws; p.coop = KL_COOP; p.pad = 0;
#if KL_COOP
    p.ph_lo = 0; p.ph_hi = NPH;
    void* args[] = {&p};
    hipError_t e = hipLaunchCooperativeKernel((const void*)mk_fwd, dim3(grid), dim3(512), args, LDS_BYTES, stream);
    if (e != hipSuccess) fprintf(stderr, "cooperative launch failed: %s (grid %d)\n", hipGetErrorString(e), grid);
#else
    for (int ph = 0; ph < NPH; ++ph) { p.ph_lo = ph; p.ph_hi = ph + 1; hipLaunchKernelGGL(mk_fwd, dim3(grid), dim3(512), LDS_BYTES, stream, p); }
#endif
}
```
